# Optimizing an MI355X kernel written in HIP

```python
import math
import jax
import jax.numpy as jnp
from jax import lax
import numpy as np

D_MODEL = 1024
BATCH = 16
SEQ = 4096
DEPTH = 4

HEAD_DIM = 128
MIX_WIDTH = D_MODEL
HALF_WIDTH = MIX_WIDTH // 2
RET_HEADS = HALF_WIDTH // HEAD_DIM
RET_WIDTH = RET_HEADS * HEAD_DIM
RET_CHUNK = 128
POOL_WINDOWS = (2, 4, 8, 16)
POOL_WIDTH = HALF_WIDTH
POOL_GROUP = POOL_WIDTH // len(POOL_WINDOWS)
LRU_WIDTH = HALF_WIDTH
LRU_BLOCKS = 8
LRU_C = 8.0
CONV_WIDTH = 4
ATT_HEADS = HALF_WIDTH // HEAD_DIM
ATT_WIDTH = ATT_HEADS * HEAD_DIM
DIL_PATTERNS = ((128, 1), (512, 4), (2048, 16))
ATT_BLOCK = 128
ROPE_THETA = 10000.0
EVEN_IN = 4 * RET_WIDTH + POOL_WIDTH
ODD_IN = 2 * LRU_WIDTH + 3 * ATT_WIDTH
D_FF = -(-8 * D_MODEL // (3 * 256)) * 256
DEEPNORM_ALPHA = (2 * DEPTH) ** 0.25
DEEPNORM_BETA = (8 * DEPTH) ** -0.25
LN_EPS = 1e-5

kernel_name = "retnet_pool_griffin_longnet_hybrid"

F32 = jnp.float32


def layer_norm(x, g, b):
    xf = x.astype(F32)
    mu = jnp.mean(xf, -1, keepdims=True)
    var = jnp.mean(jnp.square(xf - mu), -1, keepdims=True)
    return ((xf - mu) * lax.rsqrt(var + LN_EPS) * g + b).astype(x.dtype)


def rope_tables(positions, dim):
    inv = ROPE_THETA ** (-jnp.arange(0, dim, 2, dtype=F32) / dim)
    ang = positions.astype(F32)[..., None] * inv
    return jnp.cos(ang), jnp.sin(ang)


def apply_rope(t, cos, sin):
    t1, t2 = jnp.split(t.astype(F32), 2, axis=-1)
    c = cos[:, :, None, :]
    s = sin[:, :, None, :]
    return jnp.concatenate([t1 * c - t2 * s, t2 * c + t1 * s], axis=-1).astype(t.dtype)


def retention(q, k, v):
    B, S, H, dh = q.shape
    C = RET_CHUNK
    nc = S // C
    lg = jnp.log1p(-(2.0 ** (-5.0 - jnp.arange(H, dtype=F32))))
    idx = jnp.arange(C, dtype=F32)
    qc = q.astype(F32).reshape(B, nc, C, H, dh)
    kc = (k.astype(F32) * dh ** -0.5).reshape(B, nc, C, H, dh)
    vc = v.astype(F32).reshape(B, nc, C, H, dh)
    rel = idx[:, None] - idx[None, :]
    decay = jnp.where(rel[None] >= 0, jnp.exp(jnp.maximum(rel, 0.0)[None] * lg[:, None, None]), 0.0)
    scores = jnp.einsum('bnihd,bnjhd->bnhij', qc, kc) * decay
    inner = jnp.einsum('bnhij,bnjhe->bnihe', scores, vc)
    k_decay = jnp.exp((C - 1 - idx)[None, :] * lg[:, None])
    kv = jnp.einsum('bnjhd,hj,bnjhe->nbhde', kc, k_decay, vc)
    chunk_decay = jnp.exp(C * lg)[:, None, None]

    def step(state, kv_n):
        return state * chunk_decay + kv_n, state

    _, prev = lax.scan(step, jnp.zeros((B, H, dh, dh), F32), kv)
    q_decay = jnp.exp((idx + 1.0)[None, :] * lg[:, None])
    cross = jnp.einsum('bnihd,nbhde,hi->bnihe', qc, prev, q_decay)
    return (inner + cross).reshape(B, S, H, dh)


def head_group_norm(y, g):
    mu = jnp.mean(y, -1, keepdims=True)
    var = jnp.mean(jnp.square(y - mu), -1, keepdims=True)
    yn = (y - mu) * lax.rsqrt(var + LN_EPS)
    B, S, H, dh = y.shape
    return yn.reshape(B, S, H * dh) * g


def multiscale_pool(p, pool_w, pool_scale):
    B, S, _ = p.shape
    pg = p.astype(F32).reshape(B, S, len(POOL_WINDOWS), POOL_GROUP)
    cs = jnp.cumsum(pg, axis=1)
    pos1 = jnp.arange(1, S + 1)
    outs = []
    for gi, w in enumerate(POOL_WINDOWS):
        c = cs[:, :, gi]
        c_prev = jnp.pad(c, ((0, 0), (w, 0), (0, 0)))[:, :S]
        cnt = jnp.minimum(pos1, w).astype(F32)[None, :, None]
        outs.append((c - c_prev) / cnt - pg[:, :, gi])
    pooled = jnp.stack(outs, axis=2)
    mixed = jnp.einsum('bsgc,gcd->bsgd', pooled, pool_w)
    return mixed.reshape(B, S, POOL_WIDTH) * pool_scale


def causal_depthwise_conv(u, w, b):
    y = lax.conv_general_dilated(
        u, w.astype(u.dtype)[:, None, :], window_strides=(1,),
        padding=[(CONV_WIDTH - 1, 0)], dimension_numbers=('NWC', 'WIO', 'NWC'),
        feature_group_count=u.shape[-1])
    return y + b


def rg_lru(u, w_a, b_a, w_x, b_x, lam):
    B, S, R = u.shape
    uf = u.astype(F32)
    ub = uf.reshape(B, S, LRU_BLOCKS, R // LRU_BLOCKS)
    r = jax.nn.sigmoid(jnp.einsum('bsnc,ncd->bsnd', ub, w_a).reshape(B, S, R) + b_a)
    i = jax.nn.sigmoid(jnp.einsum('bsnc,ncd->bsnd', ub, w_x).reshape(B, S, R) + b_x)
    log_a = -LRU_C * r * jax.nn.softplus(-lam.astype(F32))
    a = jnp.exp(log_a)
    bseq = jnp.sqrt(-jnp.expm1(2.0 * log_a)) * (i * uf)

    def combine(left, right):
        a1, b1 = left
        a2, b2 = right
        return a1 * a2, a2 * b1 + b2

    _, h = lax.associative_scan(combine, (a, bseq), axis=1)
    return h


def banded_window_attn(q, k, v, n_back):
    N, L, H, dh = q.shape
    QB = ATT_BLOCK
    nb = -(-L // QB)
    Lp = nb * QB
    q = jnp.pad(q.astype(F32), ((0, 0), (0, Lp - L), (0, 0), (0, 0)))
    kp = jnp.pad(k.astype(F32), ((0, 0), (QB, Lp - L), (0, 0), (0, 0)))
    vp = jnp.pad(v.astype(F32), ((0, 0), (QB, Lp - L), (0, 0), (0, 0)))
    qb = q.reshape(N, nb, QB, H, dh)
    kb = jnp.concatenate([kp[:, :Lp].reshape(N, nb, QB, H, dh), kp[:, QB:].reshape(N, nb, QB, H, dh)], axis=2)
    vb = jnp.concatenate([vp[:, :Lp].reshape(N, nb, QB, H, dh), vp[:, QB:].reshape(N, nb, QB, H, dh)], axis=2)
    s = jnp.einsum('nbqhd,nbkhd->nbhqk', qb, kb)
    qpos = jnp.arange(QB)[:, None] + QB
    kpos = jnp.arange(2 * QB)[None, :]
    rel = qpos - kpos
    band = (rel >= 0) & (rel <= n_back)
    valid = band[None] & ((jnp.arange(nb)[:, None, None] > 0) | (kpos >= QB)[None])
    s = jnp.where(valid[None, :, None], s, -jnp.inf)
    m = jnp.max(s, axis=-1, keepdims=True)
    p = jnp.exp(s - m)
    den = jnp.sum(p, axis=-1, keepdims=True)
    o = jnp.einsum('nbhqk,nbkhd->nbqhd', p / den, vb).reshape(N, Lp, H, dh)[:, :L]
    lse = (m + jnp.log(den))[..., 0]
    lse = jnp.transpose(lse, (0, 1, 3, 2)).reshape(N, Lp, H)[:, :L]
    return o, lse


def dilated_attention(q, k, v):
    B, S, H, dh = q.shape
    q = q * dh ** -0.5
    outs, lses = [], []
    for window, dil in DIL_PATTERNS:
        Ld = S // dil

        def to_strided(t):
            return t.reshape(B, Ld, dil, H, dh).transpose(0, 2, 1, 3, 4).reshape(B * dil, Ld, H, dh)

        o, lse = banded_window_attn(to_strided(q), to_strided(k), to_strided(v), window // dil)
        outs.append(o.reshape(B, dil, Ld, H, dh).transpose(0, 2, 1, 3, 4).reshape(B, S, H, dh))
        lses.append(lse.reshape(B, dil, Ld, H).transpose(0, 2, 1, 3).reshape(B, S, H))
    wts = jax.nn.softmax(jnp.stack(lses, axis=0), axis=0)
    return jnp.sum(wts[..., None] * jnp.stack(outs, axis=0), axis=0)


def even_mixer(x, cos, sin, w_in, ret_norm_g, pool_w, pool_scale, w_out):
    B, S, _ = x.shape
    z = x @ w_in
    q, k, v, g, p = jnp.split(z, [RET_WIDTH, 2 * RET_WIDTH, 3 * RET_WIDTH, 4 * RET_WIDTH], axis=-1)
    heads = lambda t: t.reshape(B, S, RET_HEADS, HEAD_DIM)
    ret = retention(apply_rope(heads(q), cos, sin), apply_rope(heads(k), cos, sin), heads(v))
    ret = head_group_norm(ret, ret_norm_g) * jax.nn.silu(g.astype(F32))
    pool = multiscale_pool(p, pool_w, pool_scale)
    cat = jnp.concatenate([ret, pool], axis=-1).astype(x.dtype)
    return cat @ w_out


def odd_mixer(x, cos, sin, w_in, conv_w, conv_b, gate_a_w, gate_a_b, gate_x_w, gate_x_b, lru_lambda, w_out):
    B, S, _ = x.shape
    z = x @ w_in
    gate_in, u, q, k, v = jnp.split(
        z, [LRU_WIDTH, 2 * LRU_WIDTH, 2 * LRU_WIDTH + ATT_WIDTH, 2 * LRU_WIDTH + 2 * ATT_WIDTH], axis=-1)
    u = causal_depthwise_conv(u, conv_w, conv_b)
    y_lru = rg_lru(u, gate_a_w, gate_a_b, gate_x_w, gate_x_b, lru_lambda) * jax.nn.gelu(gate_in.astype(F32))
    heads = lambda t: t.reshape(B, S, ATT_HEADS, HEAD_DIM)
    y_att = dilated_attention(apply_rope(heads(q), cos, sin), apply_rope(heads(k), cos, sin), heads(v))
    cat = jnp.concatenate([y_lru, y_att.reshape(B, S, ATT_WIDTH)], axis=-1).astype(x.dtype)
    return cat @ w_out


def swiglu(x, w_in, w_out):
    gate, up = jnp.split(x @ w_in, 2, axis=-1)
    return (jax.nn.silu(gate) * up) @ w_out


def setup_inputs(seed: int = 0) -> dict:
    key = jax.random.key(seed)
    ks = jax.random.split(key, 24)
    D = D_MODEL
    ne = (DEPTH + 1) // 2
    no = DEPTH // 2
    bw = LRU_WIDTH // LRU_BLOCKS

    def nrm(k, shape, scale):
        return jax.random.normal(k, shape, F32) * scale

    lam_u = jax.random.uniform(ks[14], (no, LRU_WIDTH), F32, minval=0.9, maxval=0.999)
    s = lam_u ** (1.0 / LRU_C)
    lru_lambda = jnp.log(s) - jnp.log1p(-s)
    positions = jnp.broadcast_to(jnp.arange(SEQ, dtype=jnp.int32)[None, :], (BATCH, SEQ))
    return {
        "x": nrm(ks[0], (BATCH, SEQ, D), 1.0),
        "positions": positions,
        "ev_w_in": nrm(ks[1], (ne, D, EVEN_IN), D ** -0.5),
        "ev_ret_norm_g": 1.0 + nrm(ks[2], (ne, RET_WIDTH), 0.02),
        "ev_pool_w": nrm(ks[3], (ne, len(POOL_WINDOWS), POOL_GROUP, POOL_GROUP), POOL_GROUP ** -0.5),
        "ev_pool_scale": 1.0 + nrm(ks[4], (ne, POOL_WIDTH), 0.02),
        "ev_w_out": nrm(ks[5], (ne, MIX_WIDTH, D), MIX_WIDTH ** -0.5 * DEEPNORM_BETA),
        "od_w_in": nrm(ks[6], (no, D, ODD_IN), D ** -0.5),
        "od_conv_w": nrm(ks[7], (no, CONV_WIDTH, LRU_WIDTH), CONV_WIDTH ** -0.5),
        "od_conv_b": nrm(ks[8], (no, LRU_WIDTH), 0.01),
        "od_gate_a_w": nrm(ks[9], (no, LRU_BLOCKS, bw, bw), bw ** -0.5),
        "od_gate_a_b": nrm(ks[10], (no, LRU_WIDTH), 0.01),
        "od_gate_x_w": nrm(ks[11], (no, LRU_BLOCKS, bw, bw), bw ** -0.5),
        "od_gate_x_b": nrm(ks[12], (no, LRU_WIDTH), 0.01),
        "od_lru_lambda": lru_lambda,
        "od_w_out": nrm(ks[13], (no, MIX_WIDTH, D), MIX_WIDTH ** -0.5 * DEEPNORM_BETA),
        "ffn_w_in": nrm(ks[15], (DEPTH, D, 2 * D_FF), D ** -0.5),
        "ffn_w_out": nrm(ks[16], (DEPTH, D_FF, D), D_FF ** -0.5 * DEEPNORM_BETA),
        "ln_g": 1.0 + nrm(ks[17], (DEPTH, 2, D), 0.02),
        "ln_b": nrm(ks[18], (DEPTH, 2, D), 0.02),
    }


def reference(x, positions, ev_w_in, ev_ret_norm_g, ev_pool_w, ev_pool_scale, ev_w_out,
              od_w_in, od_conv_w, od_conv_b, od_gate_a_w, od_gate_a_b, od_gate_x_w, od_gate_x_b,
              od_lru_lambda, od_w_out, ffn_w_in, ffn_w_out, ln_g, ln_b):
    cos, sin = rope_tables(positions, HEAD_DIM)
    h = x
    for layer in range(DEPTH):
        j = layer // 2
        if layer % 2 == 0:
            mix = even_mixer(h, cos, sin, ev_w_in[j], ev_ret_norm_g[j], ev_pool_w[j], ev_pool_scale[j], ev_w_out[j])
        else:
            mix = odd_mixer(h, cos, sin, od_w_in[j], od_conv_w[j], od_conv_b[j], od_gate_a_w[j], od_gate_a_b[j],
                            od_gate_x_w[j], od_gate_x_b[j], od_lru_lambda[j], od_w_out[j])
        h = layer_norm(DEEPNORM_ALPHA * h + mix.astype(h.dtype), ln_g[layer, 0], ln_b[layer, 0])
        h = layer_norm(DEEPNORM_ALPHA * h + swiglu(h, ffn_w_in[layer], ffn_w_out[layer]), ln_g[layer, 1], ln_b[layer, 1])
    return h
```

```cpp
#include <hip/hip_runtime.h>
#include <hip/hip_cooperative_groups.h>
#include <math.h>
#include <cstdio>
namespace cg = cooperative_groups;

typedef unsigned short u16;
typedef short bf16x8 __attribute__((ext_vector_type(8)));
typedef short s16x4 __attribute__((ext_vector_type(4)));
typedef float f32x4 __attribute__((ext_vector_type(4)));

#define NTOK 65536
#define SEQ 4096
#define DM 1024
#define ZW 2624
#define ZN 2560
#define LDH 1088
#define LDHID 2880
#define DFF 2816
#define NTILE 256
#define DYN_LDS 139264
#define ALPHA 1.681792830507429f
#define QSCALE 0.08838834764831845f
#define LN_EPS 1e-5f

#define WOFF_IN 0L
#define WOFF_OUT 2785280L
#define WOFF_FI 3899392L
#define WOFF_FO 10027008L
#define W_PER_LAYER 12976128L
#define SLAB_ELEMS (256L * 2880L)

struct Params {
  const float* x; const int* pos;
  const float* ev_w_in; const float* ev_norm_g; const float* ev_pool_w; const float* ev_pool_scale; const float* ev_w_out;
  const float* od_w_in; const float* od_conv_w; const float* od_conv_b; const float* od_ga_w; const float* od_ga_b;
  const float* od_gx_w; const float* od_gx_b; const float* od_lam; const float* od_w_out;
  const float* ffn_w_in; const float* ffn_w_out; const float* ln_g; const float* ln_b;
  float* hf;
  u16* wbf; u16* poolwt; float* rope; u16* hb; u16* z; u16* hid; float* lse; float* agg; float* stats; unsigned* bar;
};

typedef __bf16 hbf16x2 __attribute__((ext_vector_type(2)));
typedef float hf32x2 __attribute__((ext_vector_type(2)));
__device__ __forceinline__ unsigned pack2(float a, float b) {
  hf32x2 v = {a, b};
  hbf16x2 r = __builtin_convertvector(v, hbf16x2);
  return __builtin_bit_cast(unsigned, r);
}
typedef _Float16 hf16x2 __attribute__((ext_vector_type(2)));
__device__ __forceinline__ unsigned pack2h(float a, float b) {
  hf32x2 v = {a, b};
  hf16x2 r = __builtin_convertvector(v, hf16x2);
  return __builtin_bit_cast(unsigned, r);
}
__device__ __forceinline__ float hlo(unsigned u) { return (float)__builtin_bit_cast(hf16x2, u)[0]; }
__device__ __forceinline__ float hhi(unsigned u) { return (float)__builtin_bit_cast(hf16x2, u)[1]; }
__device__ __forceinline__ u16 f2bf(float f) { return (u16)(pack2(f, 0.f) & 0xffffu); }
__device__ __forceinline__ float bflo(unsigned u) { return __uint_as_float(u << 16); }
__device__ __forceinline__ float bfhi(unsigned u) { return __uint_as_float(u & 0xffff0000u); }
__device__ __forceinline__ float bf1(u16 h) { return __uint_as_float(((unsigned)h) << 16); }
__device__ __forceinline__ f32x4 mfma16(bf16x8 x, bf16x8 y, f32x4 c) { return __builtin_amdgcn_mfma_f32_16x16x32_bf16(x, y, c, 0, 0, 0); }

__device__ __forceinline__ int lane_l() { int t = threadIdx.x & 63; asm volatile("" : "+v"(t)); return t; }
__device__ __forceinline__ int wave_l() { int w = __builtin_amdgcn_readfirstlane(threadIdx.x >> 6); asm volatile("" : "+s"(w)); return w; }

__device__ __forceinline__ bf16x8 trfrag(const char* base, int RS, int ks, int c, int lane) {
  const int g = lane >> 4, q = (lane & 15) >> 2, pp = lane & 3;
  const char* a0 = base + (32 * ks + 8 * g + q) * RS + (16 * c + 4 * pp) * 2;
  s16x4 v0 = __builtin_amdgcn_ds_read_tr16_b64_v4i16((__attribute__((address_space(3))) s16x4*)(a0));
  s16x4 v1 = __builtin_amdgcn_ds_read_tr16_b64_v4i16((__attribute__((address_space(3))) s16x4*)(a0 + 4 * RS));
  bf16x8 r;
  r[0] = v0[0]; r[1] = v0[1]; r[2] = v0[2]; r[3] = v0[3];
  r[4] = v1[0]; r[5] = v1[1]; r[6] = v1[2]; r[7] = v1[3];
  return r;
}

constexpr int BM = 256, BK = 64, HALF = 128, HT = HALF * BK;

__device__ __forceinline__ int lds_byte(int r, int c) {
  int st = (r >> 4) * 2 + (c >> 5), rr = r & 15, cc = c & 31, ob = rr * 64 + cc * 2;
  return st * 1024 + (ob ^ (((ob >> 9) & 1) << 5));
}
__device__ __forceinline__ void stage_rc(int b, int& R, int& C) {
  int st = b / 1024, sb = b % 1024, swz = sb ^ (((sb >> 9) & 1) << 5);
  R = (st >> 1) * 16 + swz / 64; C = (st & 1) * 32 + (swz % 64) / 2;
}

enum { EPI_IN = 0, EPI_RES = 1, EPI_SWIGLU = 2 };
struct EpiArgs {
  int row0;
  int mode;
  u16* z; const float* rope;
  const float* res; const u16* resb; u16* yb;
  u16* hid;
  const float* stats; const float* lng; const float* lnb; int lnmode;
};

template <int K, int epi>
__device__ __forceinline__ void gemm_tile(const u16* __restrict__ A, const u16* __restrict__ Bt,
                                          const int brow, const int bcol, const EpiArgs ea) {
  extern __shared__ __attribute__((aligned(16))) char smem[];
  const int wid = wave_l(), lane = lane_l(), tid = wid * 64 + lane, wr = wid >> 2, wc = wid & 3, fr = lane & 15, fq = lane >> 4;
  constexpr int LDK = K + 64;
  const unsigned soff = (unsigned)((tid >> 2) * LDK + (((tid & 3) ^ ((0 - (tid >> 4)) & 3)) * 8));
  constexpr bool TA = (K == DFF);
  const u16* ga = TA ? (A + (long)(brow >> 8) * SLAB_ELEMS + tid * 8) : (A + (long)brow * LDK + soff);
  const u16* gb = Bt + (long)(bcol >> 8) * (K / 32) * 8192 + tid * 8;
#define ISSUE(kt) do { \
    char* _l = smem + ((kt) & 3) * 32768 + tid * 16; \
    __builtin_amdgcn_global_load_lds((const unsigned*)(ga + (TA ? (kt) * 8192 : (kt) * 32)), (unsigned*)(_l), 16, 0, 0); \
    __builtin_amdgcn_global_load_lds((const unsigned*)(ga + (TA ? (kt) * 8192 + 4096 : (kt) * 32 + 128 * LDK)), (unsigned*)(_l + 8192), 16, 0, 0); \
    __builtin_amdgcn_global_load_lds((const unsigned*)(gb + (kt) * 8192), (unsigned*)(_l + 16384), 16, 0, 0); \
    __builtin_amdgcn_global_load_lds((const unsigned*)(gb + (kt) * 8192 + 4096), (unsigned*)(_l + 24576), 16, 0, 0); } while (0)
#define PIECE(kt, j) do { \
    char* _l = smem + ((kt) & 3) * 32768 + tid * 16 + (j) * 8192; \
    const u16* _g = ((j) & 2) ? (gb + (kt) * 8192 + (((j) & 1) ? 4096 : 0)) : (ga + (TA ? ((kt) * 8192 + (((j) & 1) ? 4096 : 0)) : ((kt) * 32 + (((j) & 1) ? 128 * LDK : 0)))); \
    __builtin_amdgcn_global_load_lds((const unsigned*)(_g), (unsigned*)(_l), 16, 0, 0); } while (0)
  f32x4 acc[8][4];
#pragma unroll
  for (int m = 0; m < 8; ++m)
#pragma unroll
    for (int n = 0; n < 4; ++n) acc[m][n] = (f32x4){0.f, 0.f, 0.f, 0.f};
  const int cpos = (fq ^ ((0 - (fr >> 2)) & 3)) * 16;
  const int aoff = (wr * 128 + fr) * 64 + cpos;
  const int boff = 16384 + (wc * 64 + fr) * 64 + cpos;
  constexpr int nt = K / 32;
  if (wr == 1) __builtin_amdgcn_s_setprio(1);
  ISSUE(0); ISSUE(1); ISSUE(2);
  asm volatile("s_waitcnt vmcnt(8)" ::: "memory");
  __builtin_amdgcn_s_barrier();
  bf16x8 B0[4], B1[4], Ac[4], An[4];
#pragma unroll
  for (int n = 0; n < 4; ++n) B0[n] = *reinterpret_cast<const bf16x8*>(smem + boff + n * 1024);
#pragma unroll
  for (int m = 0; m < 4; ++m) Ac[m] = *reinterpret_cast<const bf16x8*>(smem + aoff + m * 1024);
#define SB_ __builtin_amdgcn_sched_barrier(0)
#define MG(mi, Afrag, Bcur) do { _Pragma("unroll") for (int n = 0; n < 4; ++n) \
    acc[mi][n] = __builtin_amdgcn_mfma_f32_16x16x32_bf16(Bcur[n], Afrag, acc[mi][n], 0, 0, 0); } while (0)
#define LDA_(dst, base, mi) dst = *reinterpret_cast<const bf16x8*>((base) + aoff + (mi) * 1024)
#define LDB_(dst, base, ni) dst = *reinterpret_cast<const bf16x8*>((base) + boff + (ni) * 1024)
#define KSTEP(t, Bcur, Bnxt) do { \
    if ((t) + 1 < nt) { \
      if ((t) + 2 < nt) asm volatile("s_waitcnt vmcnt(4)" ::: "memory"); \
      else asm volatile("s_waitcnt vmcnt(0)" ::: "memory"); \
    } \
    __builtin_amdgcn_s_barrier(); \
    const char* _sc = smem + ((t) & 3) * 32768; \
    const char* _sn = smem + (((t) + 1) & 3) * 32768; \
    const bool _iss = (t) + 3 < nt, _pre = (t) + 1 < nt; \
    SB_; MG(0, Ac[0], Bcur); SB_; \
    if (_iss && wr == 0) PIECE((t) + 3, 0); \
    LDA_(An[0], _sc, 4); LDA_(An[1], _sc, 5); \
    SB_; MG(1, Ac[1], Bcur); SB_; \
    if (_iss && wr == 1) PIECE((t) + 3, 0); \
    LDA_(An[2], _sc, 6); LDA_(An[3], _sc, 7); \
    SB_; MG(2, Ac[2], Bcur); SB_; \
    if (_iss && wr == 0) PIECE((t) + 3, 1); \
    if (_pre) { LDB_(Bnxt[0], _sn, 0); LDB_(Bnxt[1], _sn, 1); } \
    SB_; MG(3, Ac[3], Bcur); SB_; \
    if (_iss && wr == 1) PIECE((t) + 3, 1); \
    if (_pre) { LDB_(Bnxt[2], _sn, 2); LDB_(Bnxt[3], _sn, 3); } \
    SB_; MG(4, An[0], Bcur); SB_; \
    if (_iss && wr == 0) PIECE((t) + 3, 2); \
    if (_pre) { LDA_(Ac[0], _sn, 0); LDA_(Ac[1], _sn, 1); } \
    SB_; MG(5, An[1], Bcur); SB_; \
    if (_iss && wr == 1) PIECE((t) + 3, 2); \
    if (_pre) { LDA_(Ac[2], _sn, 2); LDA_(Ac[3], _sn, 3); } \
    SB_; MG(6, An[2], Bcur); SB_; \
    if (_iss && wr == 0) PIECE((t) + 3, 3); \
    SB_; MG(7, An[3], Bcur); SB_; \
    if (_iss && wr == 1) PIECE((t) + 3, 3); \
    SB_; \
  } while (0)
  for (int t = 0; t < nt; t += 2) {
    KSTEP(t, B0, B1);
    KSTEP(t + 1, B1, B0);
  }
#undef KSTEP
  __builtin_amdgcn_s_setprio(0);
#undef MG
#undef LDA_
#undef LDB_
#undef SB_
#undef PIECE
#undef ISSUE
  if (epi == EPI_IN) {
#pragma unroll
    for (int m = 0; m < 8; ++m) {
      const int r = wr * 128 + m * 16 + fr;
      const long tok = (long)ea.row0 + r;
      const int d8 = (wc & 1) * 32 + fq * 8;
      const float sc = (ea.mode == 2) ? QSCALE : 1.0f;
      unsigned w1[4], w2[4];
#pragma unroll
      for (int n2 = 0; n2 < 2; ++n2) {
        float4 c01 = make_float4(1.f, 0.f, 1.f, 0.f), c23 = make_float4(1.f, 0.f, 1.f, 0.f);
        if (ea.mode) {
          const float4* cp = (const float4*)(ea.rope + tok * 128 + (d8 + n2 * 4) * 2);
          c01 = cp[0]; c23 = cp[1];
        }
        f32x4 a0 = acc[m][n2], a1 = acc[m][n2 + 2];
        const float cs[4] = {c01.x, c01.z, c23.x, c23.z};
        const float sn[4] = {c01.y, c01.w, c23.y, c23.w};
        float o1[4], o2[4];
#pragma unroll
        for (int j = 0; j < 4; ++j) {
          o1[j] = (a0[j] * cs[j] - a1[j] * sn[j]) * sc;
          o2[j] = (a1[j] * cs[j] + a0[j] * sn[j]) * sc;
        }
        w1[n2 * 2] = pack2(o1[0], o1[1]); w1[n2 * 2 + 1] = pack2(o1[2], o1[3]);
        w2[n2 * 2] = pack2(o2[0], o2[1]); w2[n2 * 2 + 1] = pack2(o2[2], o2[3]);
      }
      u16* zp = ea.z + tok * ZW + bcol + (wc >> 1) * 128 + d8;
      *(uint4*)zp = make_uint4(w1[0], w1[1], w1[2], w1[3]);
      *(uint4*)(zp + 64) = make_uint4(w2[0], w2[1], w2[2], w2[3]);
    }
  } else if (epi == EPI_RES) {
#pragma unroll
    for (int m = 0; m < 8; ++m) {
      const int r = wr * 128 + m * 16 + fr;
      const long tok = (long)ea.row0 + r;
      float mu = 0.f, rstd = 1.f;
      if (ea.lnmode) { const float2 st = *(const float2*)(ea.stats + tok * 2); mu = st.x; rstd = st.y; }
#pragma unroll
      for (int np = 0; np < 2; ++np) {
        const int col = bcol + wc * 64 + np * 32 + fq * 8;
        const long off = tok * DM + col;
        float rv[8];
        if (ea.lnmode) {
          const uint4 rb = *(const uint4*)(ea.resb + off);
          const float4 g0 = *(const float4*)(ea.lng + col), g1 = *(const float4*)(ea.lng + col + 4);
          const float4 b0 = *(const float4*)(ea.lnb + col), b1 = *(const float4*)(ea.lnb + col + 4);
          rv[0] = (hlo(rb.x) - mu) * rstd * g0.x + b0.x; rv[1] = (hhi(rb.x) - mu) * rstd * g0.y + b0.y;
          rv[2] = (hlo(rb.y) - mu) * rstd * g0.z + b0.z; rv[3] = (hhi(rb.y) - mu) * rstd * g0.w + b0.w;
          rv[4] = (hlo(rb.z) - mu) * rstd * g1.x + b1.x; rv[5] = (hhi(rb.z) - mu) * rstd * g1.y + b1.y;
          rv[6] = (hlo(rb.w) - mu) * rstd * g1.z + b1.z; rv[7] = (hhi(rb.w) - mu) * rstd * g1.w + b1.w;
        } else {
          const float4 x0 = *(const float4*)(ea.res + off), x1 = *(const float4*)(ea.res + off + 4);
          rv[0] = x0.x; rv[1] = x0.y; rv[2] = x0.z; rv[3] = x0.w; rv[4] = x1.x; rv[5] = x1.y; rv[6] = x1.z; rv[7] = x1.w;
        }
        f32x4 a0 = acc[m][2 * np], a1 = acc[m][2 * np + 1];
        uint4 ob;
        ob.x = pack2h(ALPHA * rv[0] + a0[0], ALPHA * rv[1] + a0[1]); ob.y = pack2h(ALPHA * rv[2] + a0[2], ALPHA * rv[3] + a0[3]);
        ob.z = pack2h(ALPHA * rv[4] + a1[0], ALPHA * rv[5] + a1[1]); ob.w = pack2h(ALPHA * rv[6] + a1[2], ALPHA * rv[7] + a1[3]);
        *(uint4*)(ea.yb + off) = ob;
      }
    }
  } else {
#pragma unroll
    for (int m = 0; m < 8; ++m) {
      const int r = wr * 128 + m * 16 + fr;
      unsigned wv[4];
#pragma unroll
      for (int n2 = 0; n2 < 2; ++n2) {
        f32x4 g = acc[m][n2], u = acc[m][n2 + 2];
        float o[4];
#pragma unroll
        for (int j = 0; j < 4; ++j) o[j] = g[j] * __frcp_rn(1.0f + __expf(-g[j])) * u[j];
        wv[n2 * 2] = pack2(o[0], o[1]); wv[n2 * 2 + 1] = pack2(o[2], o[3]);
      }
      char* hp = (char*)ea.hid + ((long)((bcol >> 6) + wc) * 16384 + r * 64 + ((fq ^ ((0 - (r >> 2)) & 3)) * 16));
      *(uint4*)hp = make_uint4(wv[0], wv[1], wv[2], wv[3]);
    }
  }
}
__device__ __forceinline__ int perm_src(int s, int perm) {
  if (perm == 0) return s;
  const int t = s >> 8, within = s & 255;
  const int wc = within >> 6, n = (within >> 4) & 3, i = within & 15;
  const int sub = (i >> 2) * 8 + (n & 1) * 4 + (i & 3);
  if (perm == 1) return t * 256 + (wc >> 1) * 128 + (n >> 1) * 64 + (wc & 1) * 32 + sub;
  if (perm == 2) return (n >> 1) * DFF + t * 128 + wc * 32 + sub;
  return t * 256 + wc * 64 + (n >> 1) * 32 + sub;
}

__device__ void conv_weight_tile(const float* __restrict__ W, u16* __restrict__ Bt, int K, int N, int perm, int nb, int kb, int ldb) {
  extern __shared__ __attribute__((aligned(16))) char smem[];
  float* T = (float*)smem;
  const int tid = wave_l() * 64 + lane_l();
  {
    const int nn = tid & 63, kk = tid >> 6;
    const int src = perm_src(nb * 64 + nn, perm);
#pragma unroll
    for (int r = 0; r < 8; ++r) {
      const int k = kk + 8 * r;
      T[nn * 65 + k] = W[(long)(kb * 64 + k) * N + src];
    }
  }
  __syncthreads();
  {
    const int nn = tid >> 3, kc = tid & 7;
    const float* tp = T + nn * 65 + kc * 8;
    uint4 o;
    o.x = pack2(tp[0], tp[1]); o.y = pack2(tp[2], tp[3]); o.z = pack2(tp[4], tp[5]); o.w = pack2(tp[6], tp[7]);
    if (ldb > 0) {
      *(uint4*)(Bt + (long)(nb * 64 + nn) * ldb + kb * 64 + kc * 8) = o;
    } else {
      const int n = nb * 64 + nn, k = kb * 64 + kc * 8;
      const int pn = n >> 8, r = n & 255, kt = k >> 5, c = (k & 31) >> 3;
      const int cp = c ^ ((0 - (r >> 2)) & 3);
      const long boff = ((long)pn * (K >> 5) + kt) * 16384 + r * 64 + cp * 16;
      *(uint4*)((char*)Bt + boff) = o;
    }
  }
  __syncthreads();
}

__constant__ float INV_FREQ[64] = {
  1.000000000e+00f, 8.659643531e-01f, 7.498942018e-01f, 6.493816376e-01f, 5.623413324e-01f, 4.869675338e-01f, 4.216965139e-01f, 3.651741147e-01f, 3.162277639e-01f, 2.738419771e-01f, 2.371373773e-01f, 2.053525001e-01f, 1.778279394e-01f, 1.539926529e-01f, 1.333521456e-01f, 1.154781953e-01f, 1.000000015e-01f, 8.659642935e-02f, 7.498942316e-02f, 6.493816525e-02f, 5.623413250e-02f, 4.869675264e-02f, 4.216964915e-02f, 3.651741147e-02f, 3.162277490e-02f, 2.738419548e-02f, 2.371373773e-02f, 2.053525113e-02f, 1.778279431e-02f, 1.539926510e-02f, 1.333521400e-02f, 1.154781971e-02f, 9.999999776e-03f, 8.659643121e-03f, 7.498942316e-03f, 6.493816152e-03f, 5.623413250e-03f, 4.869675264e-03f, 4.216964822e-03f, 3.651741194e-03f, 3.162277630e-03f, 2.738419687e-03f, 2.371373819e-03f, 2.053525066e-03f, 1.778279431e-03f, 1.539926510e-03f, 1.333521446e-03f, 1.154782018e-03f, 1.000000047e-03f, 8.659643354e-04f, 7.498941850e-04f, 6.493816036e-04f, 5.623413017e-04f, 4.869675322e-04f, 4.216965172e-04f, 3.651741135e-04f, 3.162277571e-04f, 2.738419571e-04f, 2.371373703e-04f, 2.053525095e-04f, 1.778279402e-04f, 1.539926598e-04f, 1.333521504e-04f, 1.154782003e-04f};

__device__ void phase0(const Params& p) {
  const int total = 4 * 3008 + 32;
  for (int t = blockIdx.x; t < total; t += gridDim.x) {
    if (t < 4 * 3008) {
      const int L = t / 3008, u = t % 3008, jl = L >> 1;
      u16* wl = p.wbf + (long)L * W_PER_LAYER;
      if (u < 640) {
        const float* W = ((L & 1) ? p.od_w_in : p.ev_w_in) + (long)jl * DM * ZN;
        conv_weight_tile(W, wl + WOFF_IN, DM, ZN, 1, u % 40, u / 40, 0);
      } else if (u < 896) {
        const int v = u - 640;
        const float* W = ((L & 1) ? p.od_w_out : p.ev_w_out) + (long)jl * DM * DM;
        conv_weight_tile(W, wl + WOFF_OUT, DM, DM, 3, v % 16, v / 16, 0);
      } else if (u < 2304) {
        const int v = u - 896;
        const float* W = p.ffn_w_in + (long)L * DM * (2 * DFF);
        conv_weight_tile(W, wl + WOFF_FI, DM, 2 * DFF, 2, v % 88, v / 88, 0);
      } else {
        const int v = u - 2304;
        const float* W = p.ffn_w_out + (long)L * DFF * DM;
        conv_weight_tile(W, wl + WOFF_FO, DFF, DM, 3, v % 16, v / 16, 0);
      }
    } else {
      const int v = t - 4 * 3008;
      const int mat = v >> 2, tt = v & 3;
      conv_weight_tile(p.ev_pool_w + (long)mat * 16384, p.poolwt + (long)mat * 16384, 128, 128, 0, tt & 1, tt >> 1, 128);
    }
  }
  const int tid0 = wave_l() * 64 + lane_l();
  for (int r = blockIdx.x; r < NTILE; r += gridDim.x) {
    for (int e = tid0; e < 256 * 64; e += 512) {
      const int row = e >> 6, i = e & 63;
      const long tok = (long)r * 256 + row;
      const float ang = (float)p.pos[tok] * INV_FREQ[i];
      float sv, cv;
      sincosf(ang, &sv, &cv);
      p.rope[tok * 128 + i * 2] = cv;
      p.rope[tok * 128 + i * 2 + 1] = sv;
    }
    for (int e = tid0; e < 256 * 256; e += 512) {
      const long row = (long)r * 256 + (e >> 8);
      const int col = (e & 255) * 4;
      float4 v = *(const float4*)(p.x + row * DM + col);
      uint2 o; o.x = pack2(v.x, v.y); o.y = pack2(v.z, v.w);
      *(uint2*)(p.hb + row * LDH + col) = o;
    }
  }
}

__device__ void ln_rows(const u16* yb, float* hf, u16* hb, long row0, const float* __restrict__ g, const float* __restrict__ b, float* stats, const bool writef32) {
  const int w = wave_l(), lane = lane_l();
  float4 gv[4], bv[4];
#pragma unroll
  for (int q = 0; q < 4; ++q) { gv[q] = *(const float4*)(g + q * 256 + lane * 4); bv[q] = *(const float4*)(b + q * 256 + lane * 4); }
  for (int rr = w; rr < 256; rr += 8) {
    float* rp = hf + (row0 + rr) * DM;
    const u16* yp = yb + (row0 + rr) * DM;
    float4 v[4];
    float s = 0.f;
#pragma unroll
    for (int q = 0; q < 4; ++q) {
      const uint2 yv = *(const uint2*)(yp + q * 256 + lane * 4);
      v[q] = make_float4(hlo(yv.x), hhi(yv.x), hlo(yv.y), hhi(yv.y));
      s += v[q].x + v[q].y + v[q].z + v[q].w;
    }
#pragma unroll
    for (int o = 32; o >= 1; o >>= 1) s += __shfl_xor(s, o);
    const float mu = s * (1.0f / 1024.0f);
    float s2 = 0.f;
#pragma unroll
    for (int q = 0; q < 4; ++q) {
      v[q].x -= mu; v[q].y -= mu; v[q].z -= mu; v[q].w -= mu;
      s2 += v[q].x * v[q].x + v[q].y * v[q].y + v[q].z * v[q].z + v[q].w * v[q].w;
    }
#pragma unroll
    for (int o = 32; o >= 1; o >>= 1) s2 += __shfl_xor(s2, o);
    const float rstd = rsqrtf(s2 * (1.0f / 1024.0f) + LN_EPS);
    if (lane == 0) { float2 st; st.x = mu; st.y = rstd; *(float2*)(stats + (row0 + rr) * 2) = st; }
    u16* bp = hb + (row0 + rr) * LDH;
#pragma unroll
    for (int q = 0; q < 4; ++q) {
      float4 o;
      o.x = v[q].x * rstd * gv[q].x + bv[q].x; o.y = v[q].y * rstd * gv[q].y + bv[q].y;
      o.z = v[q].z * rstd * gv[q].z + bv[q].z; o.w = v[q].w * rstd * gv[q].w + bv[q].w;
      if (writef32) *(float4*)(rp + q * 256 + lane * 4) = o;
      uint2 ob; ob.x = pack2(o.x, o.y); ob.y = pack2(o.z, o.w);
      *(uint2*)(bp + q * 256 + lane * 4) = ob;
    }
  }
}

__device__ void retention_item(const Params& p, int item) {
  extern __shared__ __attribute__((aligned(16))) char smem[];
  const int eq = item & 3, h = (item >> 2) & 3, b = item >> 4;
  char* Qs = smem;
  char* Ks = smem + 34816;
  char* Ps = smem + 69632;
  char* Vs = smem + 104448;
  char* V2 = smem + 114688;
  char* STs = smem + 124928;
  const int w = wave_l(), lane = lane_l(), tid = w * 64 + lane, fr = lane & 15, fq = lane >> 4;
  const float lg2 = log2f(1.0f - exp2f(-5.0f - (float)h));
  const float cdec = exp2f(128.0f * lg2);
  f32x4 sacc[2];
  sacc[0] = (f32x4){0.f, 0.f, 0.f, 0.f}; sacc[1] = sacc[0];
  for (int i = tid; i < 8704 / 4; i += 512) ((unsigned*)STs)[i] = 0u;
  const int lrow = tid >> 4, lch = tid & 15;
  uint4 rq0, rq1, rq2, rq3, rk0, rk1, rk2, rk3, rv;
#define RET_LOAD(T0) do { \
    const u16* _zq = p.z + ((T0) + lrow) * ZW + h * 128 + lch * 8; \
    rq0 = *(const uint4*)(_zq); rk0 = *(const uint4*)(_zq + 512); \
    rq1 = *(const uint4*)(_zq + 32L * ZW); rk1 = *(const uint4*)(_zq + 32L * ZW + 512); \
    rq2 = *(const uint4*)(_zq + 64L * ZW); rk2 = *(const uint4*)(_zq + 64L * ZW + 512); \
    rq3 = *(const uint4*)(_zq + 96L * ZW); rk3 = *(const uint4*)(_zq + 96L * ZW + 512); \
    rv = *(const uint4*)(p.z + ((T0) + (tid >> 2)) * ZW + 1024 + h * 128 + eq * 32 + (tid & 3) * 8); } while (0)
  RET_LOAD((long)b * SEQ);
  for (int n = 0; n < 32; ++n) {
    const long tok0 = (long)b * SEQ + n * 128;
    *(uint4*)(Qs + (lrow + 0) * 272 + lch * 16) = rq0; *(uint4*)(Qs + (lrow + 32) * 272 + lch * 16) = rq1;
    *(uint4*)(Qs + (lrow + 64) * 272 + lch * 16) = rq2; *(uint4*)(Qs + (lrow + 96) * 272 + lch * 16) = rq3;
    *(uint4*)(Ks + (lrow + 0) * 272 + lch * 16) = rk0; *(uint4*)(Ks + (lrow + 32) * 272 + lch * 16) = rk1;
    *(uint4*)(Ks + (lrow + 64) * 272 + lch * 16) = rk2; *(uint4*)(Ks + (lrow + 96) * 272 + lch * 16) = rk3;
    {
      const int row = tid >> 2, ch = tid & 3;
      const uint4 v = rv;
      *(uint4*)(Vs + row * 80 + ch * 16) = v;
      const float kd = exp2f((float)(127 - row) * lg2);
      uint4 sv;
      sv.x = pack2(bflo(v.x) * kd, bfhi(v.x) * kd); sv.y = pack2(bflo(v.y) * kd, bfhi(v.y) * kd);
      sv.z = pack2(bflo(v.z) * kd, bfhi(v.z) * kd); sv.w = pack2(bflo(v.w) * kd, bfhi(v.w) * kd);
      *(uint4*)(V2 + row * 80 + ch * 16) = sv;
    }
    __syncthreads();
    if (n + 1 < 32) { RET_LOAD(tok0 + 128); }
    bf16x8 qf[4];
#pragma unroll
    for (int ks = 0; ks < 4; ++ks) qf[ks] = *(const bf16x8*)(Qs + (w * 16 + fr) * 272 + (ks * 32 + fq * 8) * 2);
    for (int jt = 0; jt < 8; ++jt) {
      uint2 pv; pv.x = 0u; pv.y = 0u;
      if (jt <= w) {
        f32x4 a = (f32x4){0.f, 0.f, 0.f, 0.f};
#pragma unroll
        for (int ks = 0; ks < 4; ++ks) {
          bf16x8 kf = *(const bf16x8*)(Ks + (jt * 16 + fr) * 272 + (ks * 32 + fq * 8) * 2);
          a = mfma16(kf, qf[ks], a);
        }
        const int i = w * 16 + fr;
        float o[4];
#pragma unroll
        for (int jj = 0; jj < 4; ++jj) {
          const int j = jt * 16 + fq * 4 + jj;
          const int d = i - j;
          o[jj] = (d >= 0) ? a[jj] * exp2f((float)d * lg2) : 0.f;
        }
        pv.x = pack2(o[0], o[1]); pv.y = pack2(o[2], o[3]);
      }
      *(uint2*)(Ps + (w * 16 + fr) * 272 + (jt * 16 + fq * 4) * 2) = pv;
    }
    __syncthreads();
    f32x4 oin[2], ocr[2];
    oin[0] = (f32x4){0.f, 0.f, 0.f, 0.f}; oin[1] = oin[0]; ocr[0] = oin[0]; ocr[1] = oin[0];
#pragma unroll
    for (int ks = 0; ks < 4; ++ks) {
      bf16x8 pf = *(const bf16x8*)(Ps + (w * 16 + fr) * 272 + (ks * 32 + fq * 8) * 2);
#pragma unroll
      for (int et = 0; et < 2; ++et) {
        bf16x8 vf = trfrag(Vs, 80, ks, et, lane);
        oin[et] = mfma16(vf, pf, oin[et]);
        bf16x8 sf = *(const bf16x8*)(STs + (et * 16 + fr) * 272 + (ks * 32 + fq * 8) * 2);
        ocr[et] = mfma16(sf, qf[ks], ocr[et]);
      }
    }
    {
      const int i = w * 16 + fr;
      const float qd = exp2f((float)(i + 1) * lg2);
      const long tok = tok0 + i;
      u16* rp = p.hid + (tok >> 8) * SLAB_ELEMS + (tok & 255) * 512 + h * 128 + eq * 32 + fq * 4;
#pragma unroll
      for (int et = 0; et < 2; ++et) {
        uint2 s;
        s.x = pack2(oin[et][0] + qd * ocr[et][0], oin[et][1] + qd * ocr[et][1]);
        s.y = pack2(oin[et][2] + qd * ocr[et][2], oin[et][3] + qd * ocr[et][3]);
        *(uint2*)(rp + et * 16) = s;
      }
    }
    __syncthreads();
    sacc[0] *= cdec; sacc[1] *= cdec;
#pragma unroll
    for (int ks = 0; ks < 4; ++ks) {
      bf16x8 kf = trfrag(Ks, 272, ks, w, lane);
#pragma unroll
      for (int et = 0; et < 2; ++et) {
        bf16x8 vf = trfrag(V2, 80, ks, et, lane);
        sacc[et] = mfma16(kf, vf, sacc[et]);
      }
    }
#pragma unroll
    for (int et = 0; et < 2; ++et) {
      uint2 s; s.x = pack2(sacc[et][0], sacc[et][1]); s.y = pack2(sacc[et][2], sacc[et][3]);
      *(uint2*)(STs + (et * 16 + fr) * 272 + (w * 16 + fq * 4) * 2) = s;
    }
    __syncthreads();
  }
}

__device__ void finalize_even(const Params& p, int L, int r) {
  extern __shared__ __attribute__((aligned(16))) char smem[];
  const int w = wave_l(), lane = lane_l(), tid = w * 64 + lane, fr = lane & 15, fq = lane >> 4;
  const int jl = L >> 1;
  u16* cat = p.hb;
  {
    const float* gn = p.ev_norm_g + jl * 512 + lane * 8;
    float gnv[8];
#pragma unroll
    for (int i = 0; i < 8; ++i) gnv[i] = gn[i];
    const u16* slab = p.hid + (long)r * SLAB_ELEMS;
    for (int rr = w; rr < 256; rr += 8) {
      const long tok = (long)r * 256 + rr;
      uint4 rv = *(const uint4*)(slab + rr * 512 + lane * 8);
      float v[8] = {bflo(rv.x), bfhi(rv.x), bflo(rv.y), bfhi(rv.y), bflo(rv.z), bfhi(rv.z), bflo(rv.w), bfhi(rv.w)};
      float s = 0.f;
#pragma unroll
      for (int i = 0; i < 8; ++i) s += v[i];
#pragma unroll
      for (int o = 8; o >= 1; o >>= 1) s += __shfl_xor(s, o);
      const float mu = s * (1.0f / 128.0f);
      float s2 = 0.f;
#pragma unroll
      for (int i = 0; i < 8; ++i) { v[i] -= mu; s2 += v[i] * v[i]; }
#pragma unroll
      for (int o = 8; o >= 1; o >>= 1) s2 += __shfl_xor(s2, o);
      const float rstd = rsqrtf(s2 * (1.0f / 128.0f) + LN_EPS);
      uint4 gv = *(const uint4*)(p.z + tok * ZW + 1536 + lane * 8);
      float g[8] = {bflo(gv.x), bfhi(gv.x), bflo(gv.y), bfhi(gv.y), bflo(gv.z), bfhi(gv.z), bflo(gv.w), bfhi(gv.w)};
      float o[8];
#pragma unroll
      for (int i = 0; i < 8; ++i) o[i] = v[i] * rstd * gnv[i] * (g[i] / (1.0f + __expf(-g[i])));
      uint4 ov; ov.x = pack2(o[0], o[1]); ov.y = pack2(o[2], o[3]); ov.z = pack2(o[4], o[5]); ov.w = pack2(o[6], o[7]);
      *(uint4*)(cat + tok * LDH + lane * 8) = ov;
    }
  }
  char* As = smem;
  char* Ws = smem + 69632;
  for (int gi = 0; gi < 4; ++gi) {
    const int win = 2 << gi;
    __syncthreads();
    {
      const u16* wt = p.poolwt + (long)(jl * 4 + gi) * 16384;
      for (int c = tid; c < 2048; c += 512) {
        const int row = c >> 4, ch = c & 15;
        *(uint4*)(Ws + row * 272 + ch * 16) = *(const uint4*)(wt + row * 128 + ch * 8);
      }
    }
    {
      const int oct = tid & 15, seg = tid >> 4;
      const long t0 = (long)r * 256 + seg * 8;
      const int pos0 = (int)(t0 & (SEQ - 1));
      const u16* pc = p.z + 2048 + gi * 128 + oct * 8;
      float s[8];
#pragma unroll
      for (int i = 0; i < 8; ++i) s[i] = 0.f;
      for (int k = 1; k < win; ++k) {
        if (pos0 - k >= 0) {
          uint4 v = *(const uint4*)(pc + (t0 - k) * ZW);
          s[0] += bflo(v.x); s[1] += bfhi(v.x); s[2] += bflo(v.y); s[3] += bfhi(v.y);
          s[4] += bflo(v.z); s[5] += bfhi(v.z); s[6] += bflo(v.w); s[7] += bfhi(v.w);
        }
      }
      for (int i = 0; i < 8; ++i) {
        const int pos = pos0 + i;
        uint4 v = *(const uint4*)(pc + (t0 + i) * ZW);
        float cur[8] = {bflo(v.x), bfhi(v.x), bflo(v.y), bfhi(v.y), bflo(v.z), bfhi(v.z), bflo(v.w), bfhi(v.w)};
        const float icnt = 1.0f / (float)min(pos + 1, win);
        float o[8];
#pragma unroll
        for (int q = 0; q < 8; ++q) { s[q] += cur[q]; o[q] = s[q] * icnt - cur[q]; }
        uint4 ov; ov.x = pack2(o[0], o[1]); ov.y = pack2(o[2], o[3]); ov.z = pack2(o[4], o[5]); ov.w = pack2(o[6], o[7]);
        *(uint4*)(As + (seg * 8 + i) * 272 + oct * 16) = ov;
        if (pos - win + 1 >= 0) {
          uint4 u = *(const uint4*)(pc + (t0 + i - win + 1) * ZW);
          s[0] -= bflo(u.x); s[1] -= bfhi(u.x); s[2] -= bflo(u.y); s[3] -= bfhi(u.y);
          s[4] -= bflo(u.z); s[5] -= bfhi(u.z); s[6] -= bflo(u.w); s[7] -= bfhi(u.w);
        }
      }
    }
    __syncthreads();
    const float* psc = p.ev_pool_scale + jl * 512 + gi * 128;
#pragma unroll
    for (int tt = 0; tt < 2; ++tt) {
      const int trow = (w * 2 + tt) * 16 + fr;
      bf16x8 af[4];
#pragma unroll
      for (int ks = 0; ks < 4; ++ks) af[ks] = *(const bf16x8*)(As + trow * 272 + (ks * 32 + fq * 8) * 2);
      const long tok = (long)r * 256 + trow;
      for (int dt = 0; dt < 8; ++dt) {
        f32x4 a = (f32x4){0.f, 0.f, 0.f, 0.f};
#pragma unroll
        for (int ks = 0; ks < 4; ++ks) {
          bf16x8 wf = *(const bf16x8*)(Ws + (dt * 16 + fr) * 272 + (ks * 32 + fq * 8) * 2);
          a = mfma16(wf, af[ks], a);
        }
        float4 sc = *(const float4*)(psc + dt * 16 + fq * 4);
        uint2 ov; ov.x = pack2(a[0] * sc.x, a[1] * sc.y); ov.y = pack2(a[2] * sc.z, a[3] * sc.w);
        *(uint2*)(cat + tok * LDH + 512 + gi * 128 + dt * 16 + fq * 4) = ov;
      }
    }
  }
  __syncthreads();
}

template <int MODE>
__device__ void lru_tile(const Params& p, int L, int r) {
  extern __shared__ __attribute__((aligned(16))) char smem[];
  const int w = wave_l(), lane = lane_l(), tid = w * 64 + lane;
  const int jl = L >> 1, c = tid;
  float* ub = (float*)smem + w * 64;
  hf32x2 w2[64];
  {
    const float* ga = p.od_ga_w + (long)jl * 32768 + w * 4096 + lane;
    const float* gx = p.od_gx_w + (long)jl * 32768 + w * 4096 + lane;
#pragma unroll
    for (int k = 0; k < 64; ++k) { w2[k][0] = ga[k * 64]; w2[k][1] = gx[k * 64]; }
  }
  const float cw0 = p.od_conv_w[jl * 2048 + c], cw1 = p.od_conv_w[jl * 2048 + 512 + c];
  const float cw2 = p.od_conv_w[jl * 2048 + 1024 + c], cw3 = p.od_conv_w[jl * 2048 + 1536 + c];
  const float cb = p.od_conv_b[jl * 512 + c], ba = p.od_ga_b[jl * 512 + c], bx = p.od_gx_b[jl * 512 + c];
  const float lam = p.od_lam[jl * 512 + c];
  const float sp = (lam > 15.f) ? __expf(-lam) : log1pf(__expf(-lam));
  const int pos0 = (r & 15) * 256;
  const long tok0 = (long)r * 256;
  const u16* zu = p.z + 512 + c;
  float u1 = 0.f, u2 = 0.f, u3 = 0.f;
  if (pos0 > 0) { u1 = bf1(zu[(tok0 - 1) * ZW]); u2 = bf1(zu[(tok0 - 2) * ZW]); u3 = bf1(zu[(tok0 - 3) * ZW]); }
  float hst = 0.f, Ac = 1.f;
  float* aout = (float*)((char*)(p.hid + (long)r * SLAB_ELEMS) + 786432) + c;
  if (MODE == 1) {
    const int ti = r & 15;
    for (int tt = 0; tt < ti; ++tt) {
      const float2 ah = *(const float2*)(p.agg + ((long)(r - ti + tt) * 512 + c) * 2);
      hst = ah.x * hst + ah.y;
    }
  }
  for (int t8 = 0; t8 < 64; ++t8) {
    float ubat[4], gbat[4];
#pragma unroll
    for (int i = 0; i < 4; ++i) {
      ubat[i] = bf1(zu[(tok0 + t8 * 4 + i) * ZW]);
      if (MODE == 1) gbat[i] = bf1(p.z[(tok0 + t8 * 4 + i) * ZW + c]);
    }
#pragma unroll
    for (int i = 0; i < 4; ++i) {
      const float u0 = ubat[i];
      const float uc = cw0 * u3 + cw1 * u2 + cw2 * u1 + cw3 * u0 + cb;
      u3 = u2; u2 = u1; u1 = u0;
      ub[lane] = uc;
      hf32x2 r2a = {ba, bx}, r2b = {0.f, 0.f};
#pragma unroll
      for (int k4 = 0; k4 < 16; ++k4) {
        const float4 v = ((const float4*)ub)[k4];
        r2a = __builtin_elementwise_fma((hf32x2){v.x, v.x}, w2[4 * k4], r2a);
        r2b = __builtin_elementwise_fma((hf32x2){v.y, v.y}, w2[4 * k4 + 1], r2b);
        r2a = __builtin_elementwise_fma((hf32x2){v.z, v.z}, w2[4 * k4 + 2], r2a);
        r2b = __builtin_elementwise_fma((hf32x2){v.w, v.w}, w2[4 * k4 + 3], r2b);
        if ((k4 & 3) == 3) __builtin_amdgcn_sched_barrier(0);
      }
      const float ra = r2a[0] + r2b[0], rx = r2a[1] + r2b[1];
      const float rg = __frcp_rn(1.0f + __expf(-ra));
      const float ig = __frcp_rn(1.0f + __expf(-rx));
      const float la = -8.0f * rg * sp;
      const float a = __expf(la);
      const float xq = -2.0f * la;
      const float om = (xq < 0.25f) ? xq * (1.0f - xq * (0.5f - xq * (0.16666667f - xq * (0.041666668f - xq * 0.0083333338f))))
                                    : (1.0f - __expf(-xq));
      const float bq = __builtin_amdgcn_sqrtf(om) * (ig * uc);
      if (MODE == 0) {
        const u16 bqb = f2bf(bq);
        aout[(t8 * 4 + i) * 512] = a;
        p.hb[(tok0 + t8 * 4 + i) * LDH + c] = bqb;
        hst = a * hst + bf1(bqb);
      } else {
        hst = a * hst + bq;
      }
      if (MODE == 0) Ac *= a;
      if (MODE == 1) {
        const float g = gbat[i];
        const float ge = 0.5f * g * (1.0f + tanhf(0.7978845608028654f * (g + 0.044715f * g * g * g)));
        p.hb[(tok0 + t8 * 4 + i) * LDH + c] = f2bf(hst * ge);
      }
    }
  }
  if (MODE == 0) {
    float2 ah; ah.x = Ac; ah.y = hst;
    *(float2*)(p.agg + ((long)r * 512 + c) * 2) = ah;
  }
  __syncthreads();
}

__device__ void lru_gate_tile(const Params& p, int L, int r) {
  extern __shared__ __attribute__((aligned(16))) char smem[];
  const int w = wave_l(), lane = lane_l(), fr = lane & 15, fq = lane >> 4;
  const int jl = L >> 1, c = w * 64 + lane;
  char* wl = smem + w * 11264;
  char* U = wl;
  float* Ga = (float*)(wl + 2304);
  float* Gx = (float*)(wl + 2304 + 4352);
  bf16x8 wfa[4][2], wfx[4][2];
  {
    const float* ga = p.od_ga_w + (long)jl * 32768 + w * 4096;
    const float* gx = p.od_gx_w + (long)jl * 32768 + w * 4096;
#pragma unroll
    for (int dt = 0; dt < 4; ++dt)
#pragma unroll
      for (int ks = 0; ks < 2; ++ks) {
        const int k0 = ks * 32 + fq * 8, d = dt * 16 + fr;
        unsigned a4[4], x4[4];
#pragma unroll
        for (int j = 0; j < 4; ++j) {
          a4[j] = pack2(ga[(k0 + 2 * j) * 64 + d], ga[(k0 + 2 * j + 1) * 64 + d]);
          x4[j] = pack2(gx[(k0 + 2 * j) * 64 + d], gx[(k0 + 2 * j + 1) * 64 + d]);
        }
        typedef unsigned u32x4_ __attribute__((ext_vector_type(4)));
        wfa[dt][ks] = __builtin_bit_cast(bf16x8, (u32x4_){a4[0], a4[1], a4[2], a4[3]});
        wfx[dt][ks] = __builtin_bit_cast(bf16x8, (u32x4_){x4[0], x4[1], x4[2], x4[3]});
      }
  }
  const float cw0 = p.od_conv_w[jl * 2048 + c], cw1 = p.od_conv_w[jl * 2048 + 512 + c];
  const float cw2 = p.od_conv_w[jl * 2048 + 1024 + c], cw3 = p.od_conv_w[jl * 2048 + 1536 + c];
  const float cb = p.od_conv_b[jl * 512 + c], ba = p.od_ga_b[jl * 512 + c], bx = p.od_gx_b[jl * 512 + c];
  const float lam = p.od_lam[jl * 512 + c];
  const float sp = (lam > 15.f) ? __expf(-lam) : log1pf(__expf(-lam));
  const int pos0 = (r & 15) * 256;
  const long tok0 = (long)r * 256;
  const u16* zu = p.z + 512 + c;
  float u1 = 0.f, u2 = 0.f, u3 = 0.f;
  if (pos0 > 0) { u1 = bf1(zu[(tok0 - 1) * ZW]); u2 = bf1(zu[(tok0 - 2) * ZW]); u3 = bf1(zu[(tok0 - 3) * ZW]); }
  float hst = 0.f, Ac = 1.f;
  float* aout = (float*)((char*)(p.hid + (long)r * SLAB_ELEMS) + 786432) + c;
  u16 unext[16];
#pragma unroll
  for (int i = 0; i < 16; ++i) unext[i] = zu[(tok0 + i) * ZW];
  for (int g16 = 0; g16 < 16; ++g16) {
    float ucv[16];
#pragma unroll
    for (int i = 0; i < 16; ++i) {
      const float u0 = bf1(unext[i]);
      ucv[i] = cw0 * u3 + cw1 * u2 + cw2 * u1 + cw3 * u0 + cb;
      u3 = u2; u2 = u1; u1 = u0;
      *(u16*)(U + i * 144 + lane * 2) = f2bf(ucv[i]);
    }
    if (g16 < 15) {
#pragma unroll
      for (int i = 0; i < 16; ++i) unext[i] = zu[(tok0 + (g16 + 1) * 16 + i) * ZW];
    }
    const bf16x8 uf0 = *(const bf16x8*)(U + fr * 144 + (fq * 8) * 2);
    const bf16x8 uf1 = *(const bf16x8*)(U + fr * 144 + (32 + fq * 8) * 2);
#pragma unroll
    for (int dt = 0; dt < 4; ++dt) {
      f32x4 da = (f32x4){0.f, 0.f, 0.f, 0.f}, dx = (f32x4){0.f, 0.f, 0.f, 0.f};
      da = mfma16(wfa[dt][0], uf0, da); da = mfma16(wfa[dt][1], uf1, da);
      dx = mfma16(wfx[dt][0], uf0, dx); dx = mfma16(wfx[dt][1], uf1, dx);
      *(float4*)(Ga + fr * 68 + dt * 16 + fq * 4) = make_float4(da[0], da[1], da[2], da[3]);
      *(float4*)(Gx + fr * 68 + dt * 16 + fq * 4) = make_float4(dx[0], dx[1], dx[2], dx[3]);
    }
#pragma unroll
    for (int i = 0; i < 16; ++i) {
      const float uc = ucv[i];
      const float ra = Ga[i * 68 + lane] + ba, rx = Gx[i * 68 + lane] + bx;
      const float rg = __frcp_rn(1.0f + __expf(-ra));
      const float ig = __frcp_rn(1.0f + __expf(-rx));
      const float la = -8.0f * rg * sp;
      const float a = __expf(la);
      const float xq = -2.0f * la;
      const float om = (xq < 0.25f) ? xq * (1.0f - xq * (0.5f - xq * (0.16666667f - xq * (0.041666668f - xq * 0.0083333338f))))
                                    : (1.0f - __expf(-xq));
      const float bq = __builtin_amdgcn_sqrtf(om) * (ig * uc);
      const u16 bqb = f2bf(bq);
      aout[(g16 * 16 + i) * 512] = a;
      p.hb[(tok0 + g16 * 16 + i) * LDH + c] = bqb;
      hst = a * hst + bf1(bqb);
      Ac *= a;
    }
  }
  float2 ah; ah.x = Ac; ah.y = hst;
  *(float2*)(p.agg + ((long)r * 512 + c) * 2) = ah;
  __syncthreads();
}

__device__ __forceinline__ void attn_decode(const int item, int& pat, int& h, int& dil, int& blk, long& tokb) {
  pat = item >> 11;
  const int q0 = item & 2047, b = q0 >> 7, q2 = q0 & 127, s = q2 & 31;
  h = q2 >> 5;
  dil = (pat == 0) ? 1 : (pat == 1 ? 4 : 16);
  const int nblk = 32 / dil;
  const int rr = s / nblk;
  blk = s % nblk;
  tokb = (long)b * SEQ + rr;
}

__device__ void attn_items(const Params& p, const int item0, const int nitems) {
  extern __shared__ __attribute__((aligned(16))) char smem[];
  const int w = wave_l(), lane = lane_l(), tid = w * 64 + lane, fr = lane & 15, fq = lane >> 4;
  char* KVs = smem;
  char* Qs = smem + 69632;
  char* Ps = smem + 69632;
  const int lrow = tid >> 4, lch = tid & 15;
  uint4 qr0, qr1, qr2, qr3, kr[8], vr[8];
  int pat, h, dil, blk; long tokb;
  if (nitems > 0) {
    attn_decode(item0, pat, h, dil, blk, tokb);
#define QLD(dst, j, TB, DL, BK, HH) dst = *(const uint4*)(p.z + ((TB) + (long)(DL) * (128 * (BK) + lrow + 32 * (j))) * ZW + 1024 + (HH) * 128 + lch * 8)
    QLD(qr0, 0, tokb, dil, blk, h); QLD(qr1, 1, tokb, dil, blk, h); QLD(qr2, 2, tokb, dil, blk, h); QLD(qr3, 3, tokb, dil, blk, h);
#pragma unroll
    for (int j = 0; j < 8; ++j) {
      const int row = lrow + 32 * j;
      kr[j] = make_uint4(0u, 0u, 0u, 0u);
      if (blk > 0 || row >= 128) {
        const long tok = tokb + (long)dil * (128 * (blk - 1) + row);
        kr[j] = *(const uint4*)(p.z + tok * ZW + 1536 + h * 128 + lch * 8);
      }
    }
  }
  for (int n = 0; n < nitems; ++n) {
    attn_decode(item0 + n, pat, h, dil, blk, tokb);
    *(uint4*)(Qs + (lrow + 0) * 272 + lch * 16) = qr0; *(uint4*)(Qs + (lrow + 32) * 272 + lch * 16) = qr1;
    *(uint4*)(Qs + (lrow + 64) * 272 + lch * 16) = qr2; *(uint4*)(Qs + (lrow + 96) * 272 + lch * 16) = qr3;
#pragma unroll
    for (int j = 0; j < 8; ++j) *(uint4*)(KVs + (lrow + 32 * j) * 272 + lch * 16) = kr[j];
#pragma unroll
    for (int j = 0; j < 8; ++j) {
      const int row = lrow + 32 * j;
      vr[j] = make_uint4(0u, 0u, 0u, 0u);
      if (blk > 0 || row >= 128) {
        const long tok = tokb + (long)dil * (128 * (blk - 1) + row);
        vr[j] = *(const uint4*)(p.z + tok * ZW + 2048 + h * 128 + lch * 8);
      }
    }
    __syncthreads();
    bf16x8 qf[4];
#pragma unroll
    for (int ks = 0; ks < 4; ++ks) qf[ks] = *(const bf16x8*)(Qs + (w * 16 + fr) * 272 + (ks * 32 + fq * 8) * 2);
    f32x4 sc[9];
    const int i = w * 16 + fr;
    float mx = -3.0e38f;
#pragma unroll
    for (int tt = 0; tt < 9; ++tt) {
      const int kt = w + tt;
      f32x4 a = (f32x4){0.f, 0.f, 0.f, 0.f};
#pragma unroll
      for (int ks = 0; ks < 4; ++ks) {
        bf16x8 kf = *(const bf16x8*)(KVs + (kt * 16 + fr) * 272 + (ks * 32 + fq * 8) * 2);
        a = mfma16(kf, qf[ks], a);
      }
#pragma unroll
      for (int jj = 0; jj < 4; ++jj) {
        const int kk = kt * 16 + fq * 4 + jj;
        const int rel = i + 128 - kk;
        const bool valid = (rel >= 0) && (rel <= 128) && (blk > 0 || kk >= 128);
        a[jj] = valid ? a[jj] : -3.0e38f;
        mx = fmaxf(mx, a[jj]);
      }
      sc[tt] = a;
    }
    mx = fmaxf(mx, __shfl_xor(mx, 16));
    mx = fmaxf(mx, __shfl_xor(mx, 32));
    float den = 0.f;
#pragma unroll
    for (int tt = 0; tt < 9; ++tt)
#pragma unroll
      for (int jj = 0; jj < 4; ++jj) {
        const float e = (sc[tt][jj] > -1.0e38f) ? __expf(sc[tt][jj] - mx) : 0.f;
        sc[tt][jj] = e; den += e;
      }
    den += __shfl_xor(den, 16);
    den += __shfl_xor(den, 32);
    __syncthreads();
    for (int c = lane; c < 528; c += 64) *(uint4*)(Ps + w * 16 * 528 + c * 16) = make_uint4(0u, 0u, 0u, 0u);
#pragma unroll
    for (int tt = 0; tt < 9; ++tt) {
      uint2 pv; pv.x = pack2(sc[tt][0], sc[tt][1]); pv.y = pack2(sc[tt][2], sc[tt][3]);
      *(uint2*)(Ps + (w * 16 + fr) * 528 + ((w + tt) * 16 + fq * 4) * 2) = pv;
    }
#pragma unroll
    for (int j = 0; j < 8; ++j) *(uint4*)(KVs + (lrow + 32 * j) * 272 + lch * 16) = vr[j];
    if (n + 1 < nitems) {
      int pat2, h2, dil2, blk2; long tokb2;
      attn_decode(item0 + n + 1, pat2, h2, dil2, blk2, tokb2);
      QLD(qr0, 0, tokb2, dil2, blk2, h2); QLD(qr1, 1, tokb2, dil2, blk2, h2); QLD(qr2, 2, tokb2, dil2, blk2, h2); QLD(qr3, 3, tokb2, dil2, blk2, h2);
#pragma unroll
      for (int j = 0; j < 8; ++j) {
        const int row = lrow + 32 * j;
        kr[j] = make_uint4(0u, 0u, 0u, 0u);
        if (blk2 > 0 || row >= 128) {
          const long tok = tokb2 + (long)dil2 * (128 * (blk2 - 1) + row);
          kr[j] = *(const uint4*)(p.z + tok * ZW + 1536 + h2 * 128 + lch * 8);
        }
      }
    }
    __syncthreads();
    f32x4 oacc[8];
#pragma unroll
    for (int et = 0; et < 8; ++et) oacc[et] = (f32x4){0.f, 0.f, 0.f, 0.f};
    const int ks_lo = w >> 1, ks_hi = (16 * w + 143) >> 5;
    for (int ks = ks_lo; ks <= ks_hi; ++ks) {
      bf16x8 pf = *(const bf16x8*)(Ps + (w * 16 + fr) * 528 + (ks * 32 + fq * 8) * 2);
#pragma unroll
      for (int et = 0; et < 8; ++et) {
        bf16x8 vf = trfrag(KVs, 272, ks, et, lane);
        oacc[et] = mfma16(vf, pf, oacc[et]);
      }
    }
    {
      const float inv = 1.0f / den;
      const long tok = tokb + (long)dil * (128 * blk + i);
      u16* op = p.hid + (tok >> 8) * SLAB_ELEMS + (long)pat * (256 * 512) + (tok & 255) * 512 + h * 128 + fq * 4;
#pragma unroll
      for (int et = 0; et < 8; ++et) {
        uint2 ov; ov.x = pack2(oacc[et][0] * inv, oacc[et][1] * inv); ov.y = pack2(oacc[et][2] * inv, oacc[et][3] * inv);
        *(uint2*)(op + et * 16) = ov;
      }
      if (fq == 0) p.lse[((long)pat * NTOK + tok) * 4 + h] = mx + __logf(den);
    }
    __syncthreads();
  }
}

__device__ void lru_final(const Params& p, int L, int r) {
  const int w = wave_l(), lane = lane_l(), c = w * 64 + lane;
  const long tok0 = (long)r * 256;
  const int ti = r & 15;
  float hst = 0.f;
  for (int tt = 0; tt < ti; ++tt) {
    const float2 ah = *(const float2*)(p.agg + ((long)(r - ti + tt) * 512 + c) * 2);
    hst = ah.x * hst + ah.y;
  }
  const float* ap = (const float*)((const char*)(p.hid + (long)r * SLAB_ELEMS) + 786432) + c;
  u16* bp = p.hb + tok0 * LDH + c;
  const u16* gp = p.z + tok0 * ZW + c;
  for (int t8 = 0; t8 < 32; ++t8) {
    float av[8], bv[8], gv[8];
#pragma unroll
    for (int i = 0; i < 8; ++i) {
      av[i] = ap[(t8 * 8 + i) * 512];
      bv[i] = bf1(bp[(long)(t8 * 8 + i) * LDH]);
      gv[i] = bf1(gp[(long)(t8 * 8 + i) * ZW]);
    }
#pragma unroll
    for (int i = 0; i < 8; ++i) {
      hst = av[i] * hst + bv[i];
      const float g = gv[i];
      const float tg = 0.7978845608028654f * (g + 0.044715f * g * g * g);
      const float ge = g * (1.0f - __frcp_rn(1.0f + __expf(2.0f * tg)));
      bp[(long)(t8 * 8 + i) * LDH] = f2bf(hst * ge);
    }
  }
  __syncthreads();
}

__device__ void finalize_odd(const Params& p, int L, int r) {
  lru_final(p, L, r);
  const int w = wave_l(), lane = lane_l(), tid = w * 64 + lane;
  const u16* slab = p.hid + (long)r * SLAB_ELEMS;
  u16* cat = p.hb;
  const int head = lane >> 4;
  for (int rr = w; rr < 256; rr += 8) {
    const long tok = (long)r * 256 + rr;
    const float l0 = p.lse[(0L * NTOK + tok) * 4 + head];
    const float l1 = p.lse[(1L * NTOK + tok) * 4 + head];
    const float l2 = p.lse[(2L * NTOK + tok) * 4 + head];
    const float m = fmaxf(l0, fmaxf(l1, l2));
    float e0 = __expf(l0 - m), e1 = __expf(l1 - m), e2 = __expf(l2 - m);
    const float inv = 1.0f / (e0 + e1 + e2);
    e0 *= inv; e1 *= inv; e2 *= inv;
    uint4 a = *(const uint4*)(slab + 0L * (256 * 512) + rr * 512 + lane * 8);
    uint4 bq = *(const uint4*)(slab + 1L * (256 * 512) + rr * 512 + lane * 8);
    uint4 cq = *(const uint4*)(slab + 2L * (256 * 512) + rr * 512 + lane * 8);
    uint4 ov;
    ov.x = pack2(e0 * bflo(a.x) + e1 * bflo(bq.x) + e2 * bflo(cq.x), e0 * bfhi(a.x) + e1 * bfhi(bq.x) + e2 * bfhi(cq.x));
    ov.y = pack2(e0 * bflo(a.y) + e1 * bflo(bq.y) + e2 * bflo(cq.y), e0 * bfhi(a.y) + e1 * bfhi(bq.y) + e2 * bfhi(cq.y));
    ov.z = pack2(e0 * bflo(a.z) + e1 * bflo(bq.z) + e2 * bflo(cq.z), e0 * bfhi(a.z) + e1 * bfhi(bq.z) + e2 * bfhi(cq.z));
    ov.w = pack2(e0 * bflo(a.w) + e1 * bflo(bq.w) + e2 * bflo(cq.w), e0 * bfhi(a.w) + e1 * bfhi(bq.w) + e2 * bfhi(cq.w));
    *(uint4*)(cat + tok * LDH + 512 + lane * 8) = ov;
  }
  __syncthreads();
}

template <int K, int epi>
__device__ void gemm_phase(const Params& p, const u16* A, const u16* Bt, const int nN, const int Lw, const float* res, const u16* resb, u16* ydst, const int lnidx) {
  const int nM = NTILE, nwg = nM * nN, G = gridDim.x, c = blockIdx.x;
  for (int i = 0;; ++i) {
    const long Lq = (long)i * G + c;
    if (Lq >= nwg) break;
    int wgid = (int)Lq;
    {
      const int q = nwg / 8, r = nwg % 8, xcd = wgid % 8, off = wgid / 8;
      wgid = (xcd < r ? xcd * (q + 1) : r * (q + 1) + (xcd - r) * q) + off;
    }
    const int nig = 8 * nN, gid = wgid / nig, fm = gid * 8, gsz = (nM - fm) < 8 ? (nM - fm) : 8;
    const int pm = fm + ((wgid % nig) % gsz), pn = (wgid % nig) / gsz;
    EpiArgs ea;
    ea.row0 = pm * 256; ea.mode = 0; ea.z = p.z; ea.rope = p.rope; ea.res = res; ea.resb = resb; ea.yb = ydst;
    ea.hid = p.hid + (long)pm * SLAB_ELEMS;
    ea.stats = p.stats; ea.lnmode = (lnidx >= 0) ? 1 : 0;
    ea.lng = p.ln_g + (lnidx >= 0 ? lnidx : 0) * DM; ea.lnb = p.ln_b + (lnidx >= 0 ? lnidx : 0) * DM;
    if (epi == EPI_IN) {
      if (Lw & 1) ea.mode = (pn >= 4 && pn < 6) ? 2 : ((pn >= 6 && pn < 8) ? 1 : 0);
      else ea.mode = (pn < 2) ? 2 : (pn < 4 ? 1 : 0);
    }
    gemm_tile<K, epi>(A, Bt, pm * 256, pn * 256, ea);
  }
  __syncthreads();
}

#define XB_TMO      128
#define XB_XCNT(j)  (256  + 64 * (j))
#define XB_XSUB(j)  (1280 + 64 * (j))
#define XB_XGEN(j)  (2304 + 64 * (j))
#define XB_TOP      3328
#define XB_TOPGEN   3392
#define XCD_BAR_WORDS 3456
#define XB_SPIN_CAP (1u << 18)
__device__ __forceinline__ unsigned xb_ld(unsigned* p)              { return __hip_atomic_load(p, __ATOMIC_RELAXED, __HIP_MEMORY_SCOPE_AGENT); }
__device__ __forceinline__ unsigned xb_add(unsigned* p, unsigned v) { return __hip_atomic_fetch_add(p, v, __ATOMIC_RELAXED, __HIP_MEMORY_SCOPE_AGENT); }
__device__ __forceinline__ unsigned xb_xcc_id() { return (unsigned)__builtin_amdgcn_s_getreg((3 << 11) | 20) & 0xFu; }
#define XB_SPIN(cond, bar) do { unsigned _sp = 0; while (cond) { __builtin_amdgcn_s_sleep(1); \
    if ((++_sp & 255u) == 0u) { if (xb_ld(&(bar)[XB_TMO])) break; if (_sp > XB_SPIN_CAP) { atomicAdd(&(bar)[XB_TMO], 1u); break; } } } } while (0)

__device__ __forceinline__ void xcd_barrier(unsigned* bar, const unsigned x, const unsigned nloc, const unsigned nx) {
  asm volatile("s_waitcnt vmcnt(0)" ::: "memory");
  __syncthreads();
  if (threadIdx.x == 0) {
    __builtin_amdgcn_s_waitcnt(0);
    const unsigned old = xb_add(&bar[XB_XSUB(x)], 1u);
    const unsigned gen = old / nloc;
    if (old + 1u == (gen + 1u) * nloc) {
      __builtin_amdgcn_fence(__ATOMIC_RELEASE, "agent");
      asm volatile("s_waitcnt vmcnt(0)" ::: "memory");
      const unsigned og = xb_add(&bar[XB_TOP], 1u);
      const unsigned tg = og / nx;
      if (og + 1u == (tg + 1u) * nx) xb_add(&bar[XB_TOPGEN], 1u);
      else XB_SPIN(xb_ld(&bar[XB_TOPGEN]) == tg, bar);
      __builtin_amdgcn_fence(__ATOMIC_ACQUIRE, "agent");
      xb_add(&bar[XB_XGEN(x)], 1u);
      asm volatile("s_waitcnt vmcnt(0)" ::: "memory");
    } else {
      XB_SPIN(xb_ld(&bar[XB_XGEN(x)]) == gen, bar);
      __builtin_amdgcn_fence(__ATOMIC_ACQUIRE, "agent");
      asm volatile("s_waitcnt vmcnt(0)" ::: "memory");
    }
  }
  __syncthreads();
}

#ifndef DUP_GEMM
#define DUP_GEMM 0
#endif
__global__ void __launch_bounds__(512) mega(Params p, int ph0, int ph1) {
  cg::grid_group grid = cg::this_grid();
  unsigned* bar = p.bar;
  const unsigned myx = xb_xcc_id();
  unsigned nloc = 1u, nx = 1u;
  if (threadIdx.x == 0) (void)xb_add(&bar[XB_XCNT(myx)], 1u);
  for (int ph = ph0; ph < ph1; ++ph) {
    if (ph == 0) {
      phase0(p);
    } else {
      const int L = (ph - 1) >> 3, k = (ph - 1) & 7;
      u16* ybm = (u16*)p.hf;
      const u16* wl = p.wbf + (long)L * W_PER_LAYER;
      if (k == 0) {
        for (int rep = 0; rep <= DUP_GEMM; ++rep) gemm_phase<DM, EPI_IN>(p, p.hb, wl + WOFF_IN, 10, L, p.x, ybm, ybm, -1);
      } else if (k == 1) {
        if (L & 1) {
          for (int it = blockIdx.x; it < 256; it += gridDim.x) lru_gate_tile(p, L, it);
          const int i0 = (int)((long)blockIdx.x * 6144 / gridDim.x), i1 = (int)((long)(blockIdx.x + 1) * 6144 / gridDim.x);
          attn_items(p, i0, i1 - i0);
        } else {
          for (int it = blockIdx.x; it < 256; it += gridDim.x) retention_item(p, it);
        }
      } else if (k == 2) {
        for (int r = blockIdx.x; r < NTILE; r += gridDim.x) {
          if (L & 1) finalize_odd(p, L, r); else finalize_even(p, L, r);
        }
      } else if (k == 3) {
        for (int rep = 0; rep <= DUP_GEMM; ++rep) gemm_phase<DM, EPI_RES>(p, p.hb, wl + WOFF_OUT, 4, L, p.x, ybm, ybm, (L == 0) ? -1 : (L - 1) * 2 + 1);
      } else if (k == 4 || k == 7) {
        const int which = (k == 4) ? 0 : 1;
        for (int r = blockIdx.x; r < NTILE; r += gridDim.x)
          ln_rows((L == 3 && which == 1) ? (const u16*)p.z : ybm, p.hf, p.hb, (long)r * 256, p.ln_g + (L * 2 + which) * DM, p.ln_b + (L * 2 + which) * DM, p.stats, (L == 3 && which == 1));
      } else if (k == 5) {
        for (int rep = 0; rep <= DUP_GEMM; ++rep) gemm_phase<DM, EPI_SWIGLU>(p, p.hb, wl + WOFF_FI, 22, L, p.x, ybm, ybm, -1);
      } else {
        for (int rep = 0; rep <= DUP_GEMM; ++rep) gemm_phase<DFF, EPI_RES>(p, p.hid, wl + WOFF_FO, 4, L, p.x, ybm, (L == 3) ? p.z : ybm, L * 2);
      }
    }
    if (ph + 1 < ph1) {
      if (ph == ph0) {
        grid.sync();
        unsigned cnt = 0u, mine = 0u;
#pragma unroll
        for (unsigned j = 0; j < 16; ++j) { const unsigned c = xb_ld(&bar[XB_XCNT(j)]); cnt += (c > 0u) ? 1u : 0u; mine = (j == myx) ? c : mine; }
        nloc = (unsigned)__builtin_amdgcn_readfirstlane(mine > 0u ? mine : 1u);
        nx = (unsigned)__builtin_amdgcn_readfirstlane(cnt > 0u ? cnt : 1u);
      } else {
        xcd_barrier(bar, myx, nloc, nx);
      }
    }
  }
}

extern "C" void kernel_launch(void* const* d_in, const int* in_sizes, int n_in, void* d_out, int out_size,
                              void* d_ws, size_t ws_size, hipStream_t stream) {
  Params p{};
  p.x = (const float*)d_in[0]; p.pos = (const int*)d_in[1];
  p.ev_w_in = (const float*)d_in[2]; p.ev_norm_g = (const float*)d_in[3]; p.ev_pool_w = (const float*)d_in[4];
  p.ev_pool_scale = (const float*)d_in[5]; p.ev_w_out = (const float*)d_in[6];
  p.od_w_in = (const float*)d_in[7]; p.od_conv_w = (const float*)d_in[8]; p.od_conv_b = (const float*)d_in[9];
  p.od_ga_w = (const float*)d_in[10]; p.od_ga_b = (const float*)d_in[11]; p.od_gx_w = (const float*)d_in[12];
  p.od_gx_b = (const float*)d_in[13]; p.od_lam = (const float*)d_in[14]; p.od_w_out = (const float*)d_in[15];
  p.ffn_w_in = (const float*)d_in[16]; p.ffn_w_out = (const float*)d_in[17];
  p.ln_g = (const float*)d_in[18]; p.ln_b = (const float*)d_in[19];
  p.hf = (float*)d_out;
  char* ws = (char*)d_ws;
  size_t off = 0;
  p.wbf = (u16*)(ws + off); off += (size_t)4 * W_PER_LAYER * 2;
  p.poolwt = (u16*)(ws + off); off += (size_t)8 * 16384 * 2;
  p.rope = (float*)(ws + off); off += (size_t)NTOK * 128 * 4;
  p.hb = (u16*)(ws + off); off += (size_t)NTOK * LDH * 2;
  p.z = (u16*)(ws + off); off += (size_t)NTOK * ZW * 2;
  p.hid = (u16*)(ws + off); off += (size_t)NTOK * LDHID * 2;
  p.lse = (float*)(ws + off); off += (size_t)3 * NTOK * 4 * 4;
  p.agg = (float*)(ws + off); off += (size_t)NTILE * 512 * 2 * 4;
  p.stats = (float*)(ws + off); off += (size_t)NTOK * 2 * 4;
  p.bar = (unsigned*)(ws + off); off += (size_t)XCD_BAR_WORDS * 4;
  if (off > ws_size) { fprintf(stderr, "workspace too small: need %zu have %zu\n", off, ws_size); return; }
  (void)hipFuncSetAttribute((const void*)mega, hipFuncAttributeMaxDynamicSharedMemorySize, DYN_LDS);
  static int grid_blocks = 0;
  if (!grid_blocks) {
    int dev = 0, cus = 0, per_cu = 0;
    (void)hipGetDevice(&dev);
    (void)hipDeviceGetAttribute(&cus, hipDeviceAttributeMultiprocessorCount, dev);
    (void)hipOccupancyMaxActiveBlocksPerMultiprocessor(&per_cu, mega, 512, DYN_LDS);
    if (per_cu < 1) per_cu = 1;
    grid_blocks = cus * per_cu;
    if (grid_blocks > 256) grid_blocks = 256;
  }
  (void)hipMemsetAsync(p.bar, 0, (size_t)XCD_BAR_WORDS * 4, stream);
  int ph0 = 0, ph1 = 33;
  void* args[] = {&p, &ph0, &ph1};
  hipError_t e = hipLaunchCooperativeKernel((const void*)mega, dim3(grid_blocks), dim3(512), args, DYN_LDS, stream);
  if (e != hipSuccess) fprintf(stderr, "cooperative launch failed: %s (grid %d)\n", hipGetErrorString(e), grid_blocks);
}
```

```cpp
#include <hip/hip_runtime.h>
#include <hip/hip_cooperative_groups.h>
#include <math.h>
#include <cstdio>
namespace cg = cooperative_groups;

typedef unsigned short u16;
typedef short bf16x8 __attribute__((ext_vector_type(8)));
typedef short s16x4 __attribute__((ext_vector_type(4)));
typedef float f32x4 __attribute__((ext_vector_type(4)));

#define NTOK 65536
#define SEQ 4096
#define DM 1024
#define ZW 2624
#define ZN 2560
#define LDH 1088
#define LDHID 2880
#define DFF 2816
#define NTILE 256
#define DYN_LDS 139264
#define ALPHA 1.681792830507429f
#define QSCALE 0.08838834764831845f
#define LN_EPS 1e-5f

#define WOFF_IN 0L
#define WOFF_OUT 2785280L
#define WOFF_FI 3899392L
#define WOFF_FO 10027008L
#define W_PER_LAYER 12976128L
#define SLAB_ELEMS (256L * 2880L)

struct Params {
  const float* x; const int* pos;
  const float* ev_w_in; const float* ev_norm_g; const float* ev_pool_w; const float* ev_pool_scale; const float* ev_w_out;
  const float* od_w_in; const float* od_conv_w; const float* od_conv_b; const float* od_ga_w; const float* od_ga_b;
  const float* od_gx_w; const float* od_gx_b; const float* od_lam; const float* od_w_out;
  const float* ffn_w_in; const float* ffn_w_out; const float* ln_g; const float* ln_b;
  float* hf;
  u16* wbf; u16* poolwt; float* rope; u16* hb; u16* z; u16* hid; float* lse; float* agg; float* stats; unsigned* bar;
};

typedef __bf16 hbf16x2 __attribute__((ext_vector_type(2)));
typedef float hf32x2 __attribute__((ext_vector_type(2)));
__device__ __forceinline__ unsigned pack2(float a, float b) {
  hf32x2 v = {a, b};
  hbf16x2 r = __builtin_convertvector(v, hbf16x2);
  return __builtin_bit_cast(unsigned, r);
}
typedef _Float16 hf16x2 __attribute__((ext_vector_type(2)));
__device__ __forceinline__ unsigned pack2h(float a, float b) {
  hf32x2 v = {a, b};
  hf16x2 r = __builtin_convertvector(v, hf16x2);
  return __builtin_bit_cast(unsigned, r);
}
__device__ __forceinline__ float hlo(unsigned u) { return (float)__builtin_bit_cast(hf16x2, u)[0]; }
__device__ __forceinline__ float hhi(unsigned u) { return (float)__builtin_bit_cast(hf16x2, u)[1]; }
__device__ __forceinline__ u16 f2bf(float f) { return (u16)(pack2(f, 0.f) & 0xffffu); }
__device__ __forceinline__ float bflo(unsigned u) { return __uint_as_float(u << 16); }
__device__ __forceinline__ float bfhi(unsigned u) { return __uint_as_float(u & 0xffff0000u); }
__device__ __forceinline__ float bf1(u16 h) { return __uint_as_float(((unsigned)h) << 16); }
__device__ __forceinline__ f32x4 mfma16(bf16x8 x, bf16x8 y, f32x4 c) { return __builtin_amdgcn_mfma_f32_16x16x32_bf16(x, y, c, 0, 0, 0); }

__device__ __forceinline__ long hbt_off(const long tok, const int col) {
  const int r = (int)(tok & 255);
  return (tok >> 8) * 524288L + (long)(col >> 5) * 16384 + r * 64 + ((((col >> 3) & 3) ^ ((0 - (r >> 2)) & 3)) << 4) + (col & 7) * 2;
}

__device__ __forceinline__ int lane_l() { int t = threadIdx.x & 63; asm volatile("" : "+v"(t)); return t; }
__device__ __forceinline__ int wave_l() { int w = __builtin_amdgcn_readfirstlane(threadIdx.x >> 6); asm volatile("" : "+s"(w)); return w; }

__device__ __forceinline__ bf16x8 trfrag(const char* base, int RS, int ks, int c, int lane) {
  const int g = lane >> 4, q = (lane & 15) >> 2, pp = lane & 3;
  const char* a0 = base + (32 * ks + 8 * g + q) * RS + (16 * c + 4 * pp) * 2;
  s16x4 v0 = __builtin_amdgcn_ds_read_tr16_b64_v4i16((__attribute__((address_space(3))) s16x4*)(a0));
  s16x4 v1 = __builtin_amdgcn_ds_read_tr16_b64_v4i16((__attribute__((address_space(3))) s16x4*)(a0 + 4 * RS));
  bf16x8 r;
  r[0] = v0[0]; r[1] = v0[1]; r[2] = v0[2]; r[3] = v0[3];
  r[4] = v1[0]; r[5] = v1[1]; r[6] = v1[2]; r[7] = v1[3];
  return r;
}

constexpr int BM = 256, BK = 64, HALF = 128, HT = HALF * BK;

__device__ __forceinline__ int lds_byte(int r, int c) {
  int st = (r >> 4) * 2 + (c >> 5), rr = r & 15, cc = c & 31, ob = rr * 64 + cc * 2;
  return st * 1024 + (ob ^ (((ob >> 9) & 1) << 5));
}
__device__ __forceinline__ void stage_rc(int b, int& R, int& C) {
  int st = b / 1024, sb = b % 1024, swz = sb ^ (((sb >> 9) & 1) << 5);
  R = (st >> 1) * 16 + swz / 64; C = (st & 1) * 32 + (swz % 64) / 2;
}

enum { EPI_IN = 0, EPI_RES = 1, EPI_SWIGLU = 2 };
struct EpiArgs {
  int row0;
  int mode;
  u16* z; const float* rope;
  const float* res; const u16* resb; u16* yb;
  u16* hid;
  const float* stats; const float* lng; const float* lnb; int lnmode;
};

template <int K, int epi>
__device__ __forceinline__ void gemm_tile(const u16* __restrict__ A, const u16* __restrict__ Bt,
                                          const int brow, const int bcol, const EpiArgs ea) {
  extern __shared__ __attribute__((aligned(16))) char smem[];
  const int wid = wave_l(), lane = lane_l(), tid = wid * 64 + lane, wr = wid >> 2, wc = wid & 3, fr = lane & 15, fq = lane >> 4;
  constexpr int LDK = K + 64;
  const unsigned soff = (unsigned)((tid >> 2) * LDK + (((tid & 3) ^ ((0 - (tid >> 4)) & 3)) * 8));
  constexpr bool TA = (K == DFF) || (epi != EPI_RES);
  constexpr long ATILE = (K == DFF) ? SLAB_ELEMS : 262144L;
  const u16* ga = TA ? (A + (long)(brow >> 8) * ATILE + tid * 8) : (A + (long)brow * LDK + soff);
  const u16* gb = Bt + (long)(bcol >> 8) * (K / 32) * 8192 + tid * 8;
#define ISSUE(kt) do { \
    char* _l = smem + ((kt) & 3) * 32768 + tid * 16; \
    __builtin_amdgcn_global_load_lds((const unsigned*)(ga + (TA ? (kt) * 8192 : (kt) * 32)), (unsigned*)(_l), 16, 0, 0); \
    __builtin_amdgcn_global_load_lds((const unsigned*)(ga + (TA ? (kt) * 8192 + 4096 : (kt) * 32 + 128 * LDK)), (unsigned*)(_l + 8192), 16, 0, 0); \
    __builtin_amdgcn_global_load_lds((const unsigned*)(gb + (kt) * 8192), (unsigned*)(_l + 16384), 16, 0, 0); \
    __builtin_amdgcn_global_load_lds((const unsigned*)(gb + (kt) * 8192 + 4096), (unsigned*)(_l + 24576), 16, 0, 0); } while (0)
#define PIECE(kt, j) do { \
    char* _l = smem + ((kt) & 3) * 32768 + tid * 16 + (j) * 8192; \
    const u16* _g = ((j) & 2) ? (gb + (kt) * 8192 + (((j) & 1) ? 4096 : 0)) : (ga + (TA ? ((kt) * 8192 + (((j) & 1) ? 4096 : 0)) : ((kt) * 32 + (((j) & 1) ? 128 * LDK : 0)))); \
    __builtin_amdgcn_global_load_lds((const unsigned*)(_g), (unsigned*)(_l), 16, 0, 0); } while (0)
  f32x4 acc[8][4];
#pragma unroll
  for (int m = 0; m < 8; ++m)
#pragma unroll
    for (int n = 0; n < 4; ++n) acc[m][n] = (f32x4){0.f, 0.f, 0.f, 0.f};
  const int cpos = (fq ^ ((0 - (fr >> 2)) & 3)) * 16;
  const int aoff = (wr * 128 + fr) * 64 + cpos;
  const int boff = 16384 + (wc * 64 + fr) * 64 + cpos;
  constexpr int nt = K / 32;
  if (wr == 1) __builtin_amdgcn_s_setprio(1);
  ISSUE(0); ISSUE(1); ISSUE(2);
  asm volatile("s_waitcnt vmcnt(8)" ::: "memory");
  __builtin_amdgcn_s_barrier();
  bf16x8 B0[4], B1[4], Ac[4], An[4];
#pragma unroll
  for (int n = 0; n < 4; ++n) B0[n] = *reinterpret_cast<const bf16x8*>(smem + boff + n * 1024);
#pragma unroll
  for (int m = 0; m < 4; ++m) Ac[m] = *reinterpret_cast<const bf16x8*>(smem + aoff + m * 1024);
#define SB_ __builtin_amdgcn_sched_barrier(0)
#define MG(mi, Afrag, Bcur) do { _Pragma("unroll") for (int n = 0; n < 4; ++n) \
    acc[mi][n] = __builtin_amdgcn_mfma_f32_16x16x32_bf16(Bcur[n], Afrag, acc[mi][n], 0, 0, 0); } while (0)
#define LDA_(dst, base, mi) dst = *reinterpret_cast<const bf16x8*>((base) + aoff + (mi) * 1024)
#define LDB_(dst, base, ni) dst = *reinterpret_cast<const bf16x8*>((base) + boff + (ni) * 1024)
#define KSTEP(t, Bcur, Bnxt) do { \
    if ((t) + 1 < nt) { \
      if ((t) + 2 < nt) asm volatile("s_waitcnt vmcnt(4)" ::: "memory"); \
      else asm volatile("s_waitcnt vmcnt(0)" ::: "memory"); \
    } \
    __builtin_amdgcn_s_barrier(); \
    const char* _sc = smem + ((t) & 3) * 32768; \
    const char* _sn = smem + (((t) + 1) & 3) * 32768; \
    const bool _iss = (t) + 3 < nt, _pre = (t) + 1 < nt; \
    SB_; MG(0, Ac[0], Bcur); SB_; \
    if (_iss && wr == 0) PIECE((t) + 3, 0); \
    LDA_(An[0], _sc, 4); LDA_(An[1], _sc, 5); \
    SB_; MG(1, Ac[1], Bcur); SB_; \
    if (_iss && wr == 1) PIECE((t) + 3, 0); \
    LDA_(An[2], _sc, 6); LDA_(An[3], _sc, 7); \
    SB_; MG(2, Ac[2], Bcur); SB_; \
    if (_iss && wr == 0) PIECE((t) + 3, 1); \
    if (_pre) { LDB_(Bnxt[0], _sn, 0); LDB_(Bnxt[1], _sn, 1); } \
    SB_; MG(3, Ac[3], Bcur); SB_; \
    if (_iss && wr == 1) PIECE((t) + 3, 1); \
    if (_pre) { LDB_(Bnxt[2], _sn, 2); LDB_(Bnxt[3], _sn, 3); } \
    SB_; MG(4, An[0], Bcur); SB_; \
    if (_iss && wr == 0) PIECE((t) + 3, 2); \
    if (_pre) { LDA_(Ac[0], _sn, 0); LDA_(Ac[1], _sn, 1); } \
    SB_; MG(5, An[1], Bcur); SB_; \
    if (_iss && wr == 1) PIECE((t) + 3, 2); \
    if (_pre) { LDA_(Ac[2], _sn, 2); LDA_(Ac[3], _sn, 3); } \
    SB_; MG(6, An[2], Bcur); SB_; \
    if (_iss && wr == 0) PIECE((t) + 3, 3); \
    SB_; MG(7, An[3], Bcur); SB_; \
    if (_iss && wr == 1) PIECE((t) + 3, 3); \
    SB_; \
  } while (0)
  for (int t = 0; t < nt; t += 2) {
    KSTEP(t, B0, B1);
    KSTEP(t + 1, B1, B0);
  }
#undef KSTEP
  __builtin_amdgcn_s_setprio(0);
#undef MG
#undef LDA_
#undef LDB_
#undef SB_
#undef PIECE
#undef ISSUE
  if (epi == EPI_IN) {
#pragma unroll
    for (int m = 0; m < 8; ++m) {
      const int r = wr * 128 + m * 16 + fr;
      const long tok = (long)ea.row0 + r;
      const int d8 = (wc & 1) * 32 + fq * 8;
      const float sc = (ea.mode == 2) ? QSCALE : 1.0f;
      unsigned w1[4], w2[4];
#pragma unroll
      for (int n2 = 0; n2 < 2; ++n2) {
        float4 c01 = make_float4(1.f, 0.f, 1.f, 0.f), c23 = make_float4(1.f, 0.f, 1.f, 0.f);
        if (ea.mode) {
          const float4* cp = (const float4*)(ea.rope + tok * 128 + (d8 + n2 * 4) * 2);
          c01 = cp[0]; c23 = cp[1];
        }
        f32x4 a0 = acc[m][n2], a1 = acc[m][n2 + 2];
        const float cs[4] = {c01.x, c01.z, c23.x, c23.z};
        const float sn[4] = {c01.y, c01.w, c23.y, c23.w};
        float o1[4], o2[4];
#pragma unroll
        for (int j = 0; j < 4; ++j) {
          o1[j] = (a0[j] * cs[j] - a1[j] * sn[j]) * sc;
          o2[j] = (a1[j] * cs[j] + a0[j] * sn[j]) * sc;
        }
        w1[n2 * 2] = pack2(o1[0], o1[1]); w1[n2 * 2 + 1] = pack2(o1[2], o1[3]);
        w2[n2 * 2] = pack2(o2[0], o2[1]); w2[n2 * 2 + 1] = pack2(o2[2], o2[3]);
      }
      u16* zp = ea.z + tok * ZW + bcol + (wc >> 1) * 128 + d8;
      *(uint4*)zp = make_uint4(w1[0], w1[1], w1[2], w1[3]);
      *(uint4*)(zp + 64) = make_uint4(w2[0], w2[1], w2[2], w2[3]);
    }
  } else if (epi == EPI_RES) {
#pragma unroll
    for (int m = 0; m < 8; ++m) {
      const int r = wr * 128 + m * 16 + fr;
      const long tok = (long)ea.row0 + r;
      float mu = 0.f, rstd = 1.f;
      if (ea.lnmode) { const float2 st = *(const float2*)(ea.stats + tok * 2); mu = st.x; rstd = st.y; }
#pragma unroll
      for (int np = 0; np < 2; ++np) {
        const int col = bcol + wc * 64 + np * 32 + fq * 8;
        const long off = tok * DM + col;
        float rv[8];
        if (ea.lnmode) {
          const uint4 rb = *(const uint4*)(ea.resb + off);
          const float4 g0 = *(const float4*)(ea.lng + col), g1 = *(const float4*)(ea.lng + col + 4);
          const float4 b0 = *(const float4*)(ea.lnb + col), b1 = *(const float4*)(ea.lnb + col + 4);
          rv[0] = (hlo(rb.x) - mu) * rstd * g0.x + b0.x; rv[1] = (hhi(rb.x) - mu) * rstd * g0.y + b0.y;
          rv[2] = (hlo(rb.y) - mu) * rstd * g0.z + b0.z; rv[3] = (hhi(rb.y) - mu) * rstd * g0.w + b0.w;
          rv[4] = (hlo(rb.z) - mu) * rstd * g1.x + b1.x; rv[5] = (hhi(rb.z) - mu) * rstd * g1.y + b1.y;
          rv[6] = (hlo(rb.w) - mu) * rstd * g1.z + b1.z; rv[7] = (hhi(rb.w) - mu) * rstd * g1.w + b1.w;
        } else {
          const float4 x0 = *(const float4*)(ea.res + off), x1 = *(const float4*)(ea.res + off + 4);
          rv[0] = x0.x; rv[1] = x0.y; rv[2] = x0.z; rv[3] = x0.w; rv[4] = x1.x; rv[5] = x1.y; rv[6] = x1.z; rv[7] = x1.w;
        }
        f32x4 a0 = acc[m][2 * np], a1 = acc[m][2 * np + 1];
        uint4 ob;
        ob.x = pack2h(ALPHA * rv[0] + a0[0], ALPHA * rv[1] + a0[1]); ob.y = pack2h(ALPHA * rv[2] + a0[2], ALPHA * rv[3] + a0[3]);
        ob.z = pack2h(ALPHA * rv[4] + a1[0], ALPHA * rv[5] + a1[1]); ob.w = pack2h(ALPHA * rv[6] + a1[2], ALPHA * rv[7] + a1[3]);
        *(uint4*)(ea.yb + off) = ob;
      }
    }
  } else {
#pragma unroll
    for (int m = 0; m < 8; ++m) {
      const int r = wr * 128 + m * 16 + fr;
      unsigned wv[4];
#pragma unroll
      for (int n2 = 0; n2 < 2; ++n2) {
        f32x4 g = acc[m][n2], u = acc[m][n2 + 2];
        float o[4];
#pragma unroll
        for (int j = 0; j < 4; ++j) o[j] = g[j] * __frcp_rn(1.0f + __expf(-g[j])) * u[j];
        wv[n2 * 2] = pack2(o[0], o[1]); wv[n2 * 2 + 1] = pack2(o[2], o[3]);
      }
      char* hp = (char*)ea.hid + ((long)((bcol >> 6) + wc) * 16384 + r * 64 + ((fq ^ ((0 - (r >> 2)) & 3)) * 16));
      *(uint4*)hp = make_uint4(wv[0], wv[1], wv[2], wv[3]);
    }
  }
}
__device__ __forceinline__ int perm_src(int s, int perm) {
  if (perm == 0) return s;
  const int t = s >> 8, within = s & 255;
  const int wc = within >> 6, n = (within >> 4) & 3, i = within & 15;
  const int sub = (i >> 2) * 8 + (n & 1) * 4 + (i & 3);
  if (perm == 1) return t * 256 + (wc >> 1) * 128 + (n >> 1) * 64 + (wc & 1) * 32 + sub;
  if (perm == 2) return (n >> 1) * DFF + t * 128 + wc * 32 + sub;
  return t * 256 + wc * 64 + (n >> 1) * 32 + sub;
}

__device__ void conv_weight_tile(const float* __restrict__ W, u16* __restrict__ Bt, int K, int N, int perm, int nb, int kb, int ldb) {
  extern __shared__ __attribute__((aligned(16))) char smem[];
  float* T = (float*)smem;
  const int tid = wave_l() * 64 + lane_l();
  {
    const int nn = tid & 63, kk = tid >> 6;
    const int src = perm_src(nb * 64 + nn, perm);
#pragma unroll
    for (int r = 0; r < 8; ++r) {
      const int k = kk + 8 * r;
      T[nn * 65 + k] = W[(long)(kb * 64 + k) * N + src];
    }
  }
  __syncthreads();
  {
    const int nn = tid >> 3, kc = tid & 7;
    const float* tp = T + nn * 65 + kc * 8;
    uint4 o;
    o.x = pack2(tp[0], tp[1]); o.y = pack2(tp[2], tp[3]); o.z = pack2(tp[4], tp[5]); o.w = pack2(tp[6], tp[7]);
    if (ldb > 0) {
      *(uint4*)(Bt + (long)(nb * 64 + nn) * ldb + kb * 64 + kc * 8) = o;
    } else {
      const int n = nb * 64 + nn, k = kb * 64 + kc * 8;
      const int pn = n >> 8, r = n & 255, kt = k >> 5, c = (k & 31) >> 3;
      const int cp = c ^ ((0 - (r >> 2)) & 3);
      const long boff = ((long)pn * (K >> 5) + kt) * 16384 + r * 64 + cp * 16;
      *(uint4*)((char*)Bt + boff) = o;
    }
  }
  __syncthreads();
}

__constant__ float INV_FREQ[64] = {
  1.000000000e+00f, 8.659643531e-01f, 7.498942018e-01f, 6.493816376e-01f, 5.623413324e-01f, 4.869675338e-01f, 4.216965139e-01f, 3.651741147e-01f, 3.162277639e-01f, 2.738419771e-01f, 2.371373773e-01f, 2.053525001e-01f, 1.778279394e-01f, 1.539926529e-01f, 1.333521456e-01f, 1.154781953e-01f, 1.000000015e-01f, 8.659642935e-02f, 7.498942316e-02f, 6.493816525e-02f, 5.623413250e-02f, 4.869675264e-02f, 4.216964915e-02f, 3.651741147e-02f, 3.162277490e-02f, 2.738419548e-02f, 2.371373773e-02f, 2.053525113e-02f, 1.778279431e-02f, 1.539926510e-02f, 1.333521400e-02f, 1.154781971e-02f, 9.999999776e-03f, 8.659643121e-03f, 7.498942316e-03f, 6.493816152e-03f, 5.623413250e-03f, 4.869675264e-03f, 4.216964822e-03f, 3.651741194e-03f, 3.162277630e-03f, 2.738419687e-03f, 2.371373819e-03f, 2.053525066e-03f, 1.778279431e-03f, 1.539926510e-03f, 1.333521446e-03f, 1.154782018e-03f, 1.000000047e-03f, 8.659643354e-04f, 7.498941850e-04f, 6.493816036e-04f, 5.623413017e-04f, 4.869675322e-04f, 4.216965172e-04f, 3.651741135e-04f, 3.162277571e-04f, 2.738419571e-04f, 2.371373703e-04f, 2.053525095e-04f, 1.778279402e-04f, 1.539926598e-04f, 1.333521504e-04f, 1.154782003e-04f};

__device__ void phase0(const Params& p) {
  const int total = 4 * 3008 + 32;
  for (int t = blockIdx.x; t < total; t += gridDim.x) {
    if (t < 4 * 3008) {
      const int L = t / 3008, u = t % 3008, jl = L >> 1;
      u16* wl = p.wbf + (long)L * W_PER_LAYER;
      if (u < 640) {
        const float* W = ((L & 1) ? p.od_w_in : p.ev_w_in) + (long)jl * DM * ZN;
        conv_weight_tile(W, wl + WOFF_IN, DM, ZN, 1, u % 40, u / 40, 0);
      } else if (u < 896) {
        const int v = u - 640;
        const float* W = ((L & 1) ? p.od_w_out : p.ev_w_out) + (long)jl * DM * DM;
        conv_weight_tile(W, wl + WOFF_OUT, DM, DM, 3, v % 16, v / 16, 0);
      } else if (u < 2304) {
        const int v = u - 896;
        const float* W = p.ffn_w_in + (long)L * DM * (2 * DFF);
        conv_weight_tile(W, wl + WOFF_FI, DM, 2 * DFF, 2, v % 88, v / 88, 0);
      } else {
        const int v = u - 2304;
        const float* W = p.ffn_w_out + (long)L * DFF * DM;
        conv_weight_tile(W, wl + WOFF_FO, DFF, DM, 3, v % 16, v / 16, 0);
      }
    } else {
      const int v = t - 4 * 3008;
      const int mat = v >> 2, tt = v & 3;
      conv_weight_tile(p.ev_pool_w + (long)mat * 16384, p.poolwt + (long)mat * 16384, 128, 128, 0, tt & 1, tt >> 1, 128);
    }
  }
  const int tid0 = wave_l() * 64 + lane_l();
  for (int r = blockIdx.x; r < NTILE; r += gridDim.x) {
    for (int e = tid0; e < 256 * 64; e += 512) {
      const int row = e >> 6, i = e & 63;
      const long tok = (long)r * 256 + row;
      const float ang = (float)p.pos[tok] * INV_FREQ[i];
      float sv, cv;
      sincosf(ang, &sv, &cv);
      p.rope[tok * 128 + i * 2] = cv;
      p.rope[tok * 128 + i * 2 + 1] = sv;
    }
    for (int e = tid0; e < 256 * 256; e += 512) {
      const long row = (long)r * 256 + (e >> 8);
      const int col = (e & 255) * 4;
      float4 v = *(const float4*)(p.x + row * DM + col);
      uint2 o; o.x = pack2(v.x, v.y); o.y = pack2(v.z, v.w);
      *(uint2*)((char*)p.hb + hbt_off(row, col)) = o;
    }
  }
}

__device__ void ln_rows(const u16* yb, float* hf, u16* hb, long row0, const float* __restrict__ g, const float* __restrict__ b, float* stats, const bool writef32) {
  const int w = wave_l(), lane = lane_l();
  const int ksel = lane >> 4, rsel = (lane >> 3) & 1, p8 = lane & 7;
  const int cbase = ksel * 32 + p8 * 4;
  for (int pr = 0; pr < 16; ++pr) {
    const long row = row0 + w * 32 + pr * 2 + rsel;
    const u16* yp = yb + row * DM + cbase;
    float4 v[8];
    float s = 0.f;
#pragma unroll
    for (int s8 = 0; s8 < 8; ++s8) {
      const uint2 yv = *(const uint2*)(yp + s8 * 128);
      v[s8] = make_float4(hlo(yv.x), hhi(yv.x), hlo(yv.y), hhi(yv.y));
      s += v[s8].x + v[s8].y + v[s8].z + v[s8].w;
    }
    s += __shfl_xor(s, 1); s += __shfl_xor(s, 2); s += __shfl_xor(s, 4); s += __shfl_xor(s, 16); s += __shfl_xor(s, 32);
    const float mu = s * (1.0f / 1024.0f);
    float s2 = 0.f;
#pragma unroll
    for (int s8 = 0; s8 < 8; ++s8) {
      v[s8].x -= mu; v[s8].y -= mu; v[s8].z -= mu; v[s8].w -= mu;
      s2 += v[s8].x * v[s8].x + v[s8].y * v[s8].y + v[s8].z * v[s8].z + v[s8].w * v[s8].w;
    }
    s2 += __shfl_xor(s2, 1); s2 += __shfl_xor(s2, 2); s2 += __shfl_xor(s2, 4); s2 += __shfl_xor(s2, 16); s2 += __shfl_xor(s2, 32);
    const float rstd = rsqrtf(s2 * (1.0f / 1024.0f) + LN_EPS);
    if ((lane & 55) == 0) { float2 st; st.x = mu; st.y = rstd; *(float2*)(stats + row * 2) = st; }
#pragma unroll
    for (int s8 = 0; s8 < 8; ++s8) {
      const int col = s8 * 128 + cbase;
      const float4 g4 = *(const float4*)(g + col), b4 = *(const float4*)(b + col);
      float4 o;
      o.x = v[s8].x * rstd * g4.x + b4.x; o.y = v[s8].y * rstd * g4.y + b4.y;
      o.z = v[s8].z * rstd * g4.z + b4.z; o.w = v[s8].w * rstd * g4.w + b4.w;
      if (writef32) *(float4*)(hf + row * DM + col) = o;
      uint2 ob; ob.x = pack2(o.x, o.y); ob.y = pack2(o.z, o.w);
      *(uint2*)((char*)hb + hbt_off(row, col)) = ob;
    }
  }
}

__device__ void retention_item(const Params& p, int item) {
  extern __shared__ __attribute__((aligned(16))) char smem[];
  const int eq = item & 3, h = (item >> 2) & 3, b = item >> 4;
  char* Qs = smem;
  char* Ks = smem + 34816;
  char* Ps = smem + 69632;
  char* Vs = smem + 104448;
  char* V2 = smem + 114688;
  char* STs = smem + 124928;
  const int w = wave_l(), lane = lane_l(), tid = w * 64 + lane, fr = lane & 15, fq = lane >> 4;
  const float lg2 = log2f(1.0f - exp2f(-5.0f - (float)h));
  const float cdec = exp2f(128.0f * lg2);
  f32x4 sacc[2];
  sacc[0] = (f32x4){0.f, 0.f, 0.f, 0.f}; sacc[1] = sacc[0];
  for (int i = tid; i < 8704 / 4; i += 512) ((unsigned*)STs)[i] = 0u;
  const int lrow = tid >> 4, lch = tid & 15;
  uint4 rq0, rq1, rq2, rq3, rk0, rk1, rk2, rk3, rv;
#define RET_LOAD(T0) do { \
    const u16* _zq = p.z + ((T0) + lrow) * ZW + h * 128 + lch * 8; \
    rq0 = *(const uint4*)(_zq); rk0 = *(const uint4*)(_zq + 512); \
    rq1 = *(const uint4*)(_zq + 32L * ZW); rk1 = *(const uint4*)(_zq + 32L * ZW + 512); \
    rq2 = *(const uint4*)(_zq + 64L * ZW); rk2 = *(const uint4*)(_zq + 64L * ZW + 512); \
    rq3 = *(const uint4*)(_zq + 96L * ZW); rk3 = *(const uint4*)(_zq + 96L * ZW + 512); \
    rv = *(const uint4*)(p.z + ((T0) + (tid >> 2)) * ZW + 1024 + h * 128 + eq * 32 + (tid & 3) * 8); } while (0)
  RET_LOAD((long)b * SEQ);
  for (int n = 0; n < 32; ++n) {
    const long tok0 = (long)b * SEQ + n * 128;
    *(uint4*)(Qs + (lrow + 0) * 272 + lch * 16) = rq0; *(uint4*)(Qs + (lrow + 32) * 272 + lch * 16) = rq1;
    *(uint4*)(Qs + (lrow + 64) * 272 + lch * 16) = rq2; *(uint4*)(Qs + (lrow + 96) * 272 + lch * 16) = rq3;
    *(uint4*)(Ks + (lrow + 0) * 272 + lch * 16) = rk0; *(uint4*)(Ks + (lrow + 32) * 272 + lch * 16) = rk1;
    *(uint4*)(Ks + (lrow + 64) * 272 + lch * 16) = rk2; *(uint4*)(Ks + (lrow + 96) * 272 + lch * 16) = rk3;
    {
      const int row = tid >> 2, ch = tid & 3;
      const uint4 v = rv;
      *(uint4*)(Vs + row * 80 + ch * 16) = v;
      const float kd = exp2f((float)(127 - row) * lg2);
      uint4 sv;
      sv.x = pack2(bflo(v.x) * kd, bfhi(v.x) * kd); sv.y = pack2(bflo(v.y) * kd, bfhi(v.y) * kd);
      sv.z = pack2(bflo(v.z) * kd, bfhi(v.z) * kd); sv.w = pack2(bflo(v.w) * kd, bfhi(v.w) * kd);
      *(uint4*)(V2 + row * 80 + ch * 16) = sv;
    }
    __syncthreads();
    if (n + 1 < 32) { RET_LOAD(tok0 + 128); }
    bf16x8 qf[4];
#pragma unroll
    for (int ks = 0; ks < 4; ++ks) qf[ks] = *(const bf16x8*)(Qs + (w * 16 + fr) * 272 + (ks * 32 + fq * 8) * 2);
    for (int jt = 0; jt < 8; ++jt) {
      uint2 pv; pv.x = 0u; pv.y = 0u;
      if (jt <= w) {
        f32x4 a = (f32x4){0.f, 0.f, 0.f, 0.f};
#pragma unroll
        for (int ks = 0; ks < 4; ++ks) {
          bf16x8 kf = *(const bf16x8*)(Ks + (jt * 16 + fr) * 272 + (ks * 32 + fq * 8) * 2);
          a = mfma16(kf, qf[ks], a);
        }
        const int i = w * 16 + fr;
        float o[4];
#pragma unroll
        for (int jj = 0; jj < 4; ++jj) {
          const int j = jt * 16 + fq * 4 + jj;
          const int d = i - j;
          o[jj] = (d >= 0) ? a[jj] * exp2f((float)d * lg2) : 0.f;
        }
        pv.x = pack2(o[0], o[1]); pv.y = pack2(o[2], o[3]);
      }
      *(uint2*)(Ps + (w * 16 + fr) * 272 + (jt * 16 + fq * 4) * 2) = pv;
    }
    __syncthreads();
    f32x4 oin[2], ocr[2];
    oin[0] = (f32x4){0.f, 0.f, 0.f, 0.f}; oin[1] = oin[0]; ocr[0] = oin[0]; ocr[1] = oin[0];
#pragma unroll
    for (int ks = 0; ks < 4; ++ks) {
      bf16x8 pf = *(const bf16x8*)(Ps + (w * 16 + fr) * 272 + (ks * 32 + fq * 8) * 2);
#pragma unroll
      for (int et = 0; et < 2; ++et) {
        bf16x8 vf = trfrag(Vs, 80, ks, et, lane);
        oin[et] = mfma16(vf, pf, oin[et]);
        bf16x8 sf = *(const bf16x8*)(STs + (et * 16 + fr) * 272 + (ks * 32 + fq * 8) * 2);
        ocr[et] = mfma16(sf, qf[ks], ocr[et]);
      }
    }
    {
      const int i = w * 16 + fr;
      const float qd = exp2f((float)(i + 1) * lg2);
      const long tok = tok0 + i;
      u16* rp = p.hid + (tok >> 8) * SLAB_ELEMS + (tok & 255) * 512 + h * 128 + eq * 32 + fq * 4;
#pragma unroll
      for (int et = 0; et < 2; ++et) {
        uint2 s;
        s.x = pack2(oin[et][0] + qd * ocr[et][0], oin[et][1] + qd * ocr[et][1]);
        s.y = pack2(oin[et][2] + qd * ocr[et][2], oin[et][3] + qd * ocr[et][3]);
        *(uint2*)(rp + et * 16) = s;
      }
    }
    __syncthreads();
    sacc[0] *= cdec; sacc[1] *= cdec;
#pragma unroll
    for (int ks = 0; ks < 4; ++ks) {
      bf16x8 kf = trfrag(Ks, 272, ks, w, lane);
#pragma unroll
      for (int et = 0; et < 2; ++et) {
        bf16x8 vf = trfrag(V2, 80, ks, et, lane);
        sacc[et] = mfma16(kf, vf, sacc[et]);
      }
    }
#pragma unroll
    for (int et = 0; et < 2; ++et) {
      uint2 s; s.x = pack2(sacc[et][0], sacc[et][1]); s.y = pack2(sacc[et][2], sacc[et][3]);
      *(uint2*)(STs + (et * 16 + fr) * 272 + (w * 16 + fq * 4) * 2) = s;
    }
    __syncthreads();
  }
}

__device__ void finalize_even(const Params& p, int L, int r) {
  extern __shared__ __attribute__((aligned(16))) char smem[];
  const int w = wave_l(), lane = lane_l(), tid = w * 64 + lane, fr = lane & 15, fq = lane >> 4;
  const int jl = L >> 1;
  u16* cat = p.hb;
  {
    const float* gn = p.ev_norm_g + jl * 512 + lane * 8;
    float gnv[8];
#pragma unroll
    for (int i = 0; i < 8; ++i) gnv[i] = gn[i];
    const u16* slab = p.hid + (long)r * SLAB_ELEMS;
    for (int rr = w; rr < 256; rr += 8) {
      const long tok = (long)r * 256 + rr;
      uint4 rv = *(const uint4*)(slab + rr * 512 + lane * 8);
      float v[8] = {bflo(rv.x), bfhi(rv.x), bflo(rv.y), bfhi(rv.y), bflo(rv.z), bfhi(rv.z), bflo(rv.w), bfhi(rv.w)};
      float s = 0.f;
#pragma unroll
      for (int i = 0; i < 8; ++i) s += v[i];
#pragma unroll
      for (int o = 8; o >= 1; o >>= 1) s += __shfl_xor(s, o);
      const float mu = s * (1.0f / 128.0f);
      float s2 = 0.f;
#pragma unroll
      for (int i = 0; i < 8; ++i) { v[i] -= mu; s2 += v[i] * v[i]; }
#pragma unroll
      for (int o = 8; o >= 1; o >>= 1) s2 += __shfl_xor(s2, o);
      const float rstd = rsqrtf(s2 * (1.0f / 128.0f) + LN_EPS);
      uint4 gv = *(const uint4*)(p.z + tok * ZW + 1536 + lane * 8);
      float g[8] = {bflo(gv.x), bfhi(gv.x), bflo(gv.y), bfhi(gv.y), bflo(gv.z), bfhi(gv.z), bflo(gv.w), bfhi(gv.w)};
      float o[8];
#pragma unroll
      for (int i = 0; i < 8; ++i) o[i] = v[i] * rstd * gnv[i] * (g[i] / (1.0f + __expf(-g[i])));
      uint4 ov; ov.x = pack2(o[0], o[1]); ov.y = pack2(o[2], o[3]); ov.z = pack2(o[4], o[5]); ov.w = pack2(o[6], o[7]);
      *(uint4*)(cat + tok * LDH + lane * 8) = ov;
    }
  }
  char* As = smem;
  char* Ws = smem + 69632;
  for (int gi = 0; gi < 4; ++gi) {
    const int win = 2 << gi;
    __syncthreads();
    {
      const u16* wt = p.poolwt + (long)(jl * 4 + gi) * 16384;
      for (int c = tid; c < 2048; c += 512) {
        const int row = c >> 4, ch = c & 15;
        *(uint4*)(Ws + row * 272 + ch * 16) = *(const uint4*)(wt + row * 128 + ch * 8);
      }
    }
    {
      const int oct = tid & 15, seg = tid >> 4;
      const long t0 = (long)r * 256 + seg * 8;
      const int pos0 = (int)(t0 & (SEQ - 1));
      const u16* pc = p.z + 2048 + gi * 128 + oct * 8;
      float s[8];
#pragma unroll
      for (int i = 0; i < 8; ++i) s[i] = 0.f;
      for (int k = 1; k < win; ++k) {
        if (pos0 - k >= 0) {
          uint4 v = *(const uint4*)(pc + (t0 - k) * ZW);
          s[0] += bflo(v.x); s[1] += bfhi(v.x); s[2] += bflo(v.y); s[3] += bfhi(v.y);
          s[4] += bflo(v.z); s[5] += bfhi(v.z); s[6] += bflo(v.w); s[7] += bfhi(v.w);
        }
      }
      for (int i = 0; i < 8; ++i) {
        const int pos = pos0 + i;
        uint4 v = *(const uint4*)(pc + (t0 + i) * ZW);
        float cur[8] = {bflo(v.x), bfhi(v.x), bflo(v.y), bfhi(v.y), bflo(v.z), bfhi(v.z), bflo(v.w), bfhi(v.w)};
        const float icnt = 1.0f / (float)min(pos + 1, win);
        float o[8];
#pragma unroll
        for (int q = 0; q < 8; ++q) { s[q] += cur[q]; o[q] = s[q] * icnt - cur[q]; }
        uint4 ov; ov.x = pack2(o[0], o[1]); ov.y = pack2(o[2], o[3]); ov.z = pack2(o[4], o[5]); ov.w = pack2(o[6], o[7]);
        *(uint4*)(As + (seg * 8 + i) * 272 + oct * 16) = ov;
        if (pos - win + 1 >= 0) {
          uint4 u = *(const uint4*)(pc + (t0 + i - win + 1) * ZW);
          s[0] -= bflo(u.x); s[1] -= bfhi(u.x); s[2] -= bflo(u.y); s[3] -= bfhi(u.y);
          s[4] -= bflo(u.z); s[5] -= bfhi(u.z); s[6] -= bflo(u.w); s[7] -= bfhi(u.w);
        }
      }
    }
    __syncthreads();
    const float* psc = p.ev_pool_scale + jl * 512 + gi * 128;
#pragma unroll
    for (int tt = 0; tt < 2; ++tt) {
      const int trow = (w * 2 + tt) * 16 + fr;
      bf16x8 af[4];
#pragma unroll
      for (int ks = 0; ks < 4; ++ks) af[ks] = *(const bf16x8*)(As + trow * 272 + (ks * 32 + fq * 8) * 2);
      const long tok = (long)r * 256 + trow;
      for (int dt = 0; dt < 8; ++dt) {
        f32x4 a = (f32x4){0.f, 0.f, 0.f, 0.f};
#pragma unroll
        for (int ks = 0; ks < 4; ++ks) {
          bf16x8 wf = *(const bf16x8*)(Ws + (dt * 16 + fr) * 272 + (ks * 32 + fq * 8) * 2);
          a = mfma16(wf, af[ks], a);
        }
        float4 sc = *(const float4*)(psc + dt * 16 + fq * 4);
        uint2 ov; ov.x = pack2(a[0] * sc.x, a[1] * sc.y); ov.y = pack2(a[2] * sc.z, a[3] * sc.w);
        *(uint2*)(cat + tok * LDH + 512 + gi * 128 + dt * 16 + fq * 4) = ov;
      }
    }
  }
  __syncthreads();
}

template <int MODE>
__device__ void lru_tile(const Params& p, int L, int r) {
  extern __shared__ __attribute__((aligned(16))) char smem[];
  const int w = wave_l(), lane = lane_l(), tid = w * 64 + lane;
  const int jl = L >> 1, c = tid;
  float* ub = (float*)smem + w * 64;
  hf32x2 w2[64];
  {
    const float* ga = p.od_ga_w + (long)jl * 32768 + w * 4096 + lane;
    const float* gx = p.od_gx_w + (long)jl * 32768 + w * 4096 + lane;
#pragma unroll
    for (int k = 0; k < 64; ++k) { w2[k][0] = ga[k * 64]; w2[k][1] = gx[k * 64]; }
  }
  const float cw0 = p.od_conv_w[jl * 2048 + c], cw1 = p.od_conv_w[jl * 2048 + 512 + c];
  const float cw2 = p.od_conv_w[jl * 2048 + 1024 + c], cw3 = p.od_conv_w[jl * 2048 + 1536 + c];
  const float cb = p.od_conv_b[jl * 512 + c], ba = p.od_ga_b[jl * 512 + c], bx = p.od_gx_b[jl * 512 + c];
  const float lam = p.od_lam[jl * 512 + c];
  const float sp = (lam > 15.f) ? __expf(-lam) : log1pf(__expf(-lam));
  const int pos0 = (r & 15) * 256;
  const long tok0 = (long)r * 256;
  const u16* zu = p.z + 512 + c;
  float u1 = 0.f, u2 = 0.f, u3 = 0.f;
  if (pos0 > 0) { u1 = bf1(zu[(tok0 - 1) * ZW]); u2 = bf1(zu[(tok0 - 2) * ZW]); u3 = bf1(zu[(tok0 - 3) * ZW]); }
  float hst = 0.f, Ac = 1.f;
  float* aout = (float*)((char*)(p.hid + (long)r * SLAB_ELEMS) + 786432) + c;
  if (MODE == 1) {
    const int ti = r & 15;
    for (int tt = 0; tt < ti; ++tt) {
      const float2 ah = *(const float2*)(p.agg + ((long)(r - ti + tt) * 512 + c) * 2);
      hst = ah.x * hst + ah.y;
    }
  }
  for (int t8 = 0; t8 < 64; ++t8) {
    float ubat[4], gbat[4];
#pragma unroll
    for (int i = 0; i < 4; ++i) {
      ubat[i] = bf1(zu[(tok0 + t8 * 4 + i) * ZW]);
      if (MODE == 1) gbat[i] = bf1(p.z[(tok0 + t8 * 4 + i) * ZW + c]);
    }
#pragma unroll
    for (int i = 0; i < 4; ++i) {
      const float u0 = ubat[i];
      const float uc = cw0 * u3 + cw1 * u2 + cw2 * u1 + cw3 * u0 + cb;
      u3 = u2; u2 = u1; u1 = u0;
      ub[lane] = uc;
      hf32x2 r2a = {ba, bx}, r2b = {0.f, 0.f};
#pragma unroll
      for (int k4 = 0; k4 < 16; ++k4) {
        const float4 v = ((const float4*)ub)[k4];
        r2a = __builtin_elementwise_fma((hf32x2){v.x, v.x}, w2[4 * k4], r2a);
        r2b = __builtin_elementwise_fma((hf32x2){v.y, v.y}, w2[4 * k4 + 1], r2b);
        r2a = __builtin_elementwise_fma((hf32x2){v.z, v.z}, w2[4 * k4 + 2], r2a);
        r2b = __builtin_elementwise_fma((hf32x2){v.w, v.w}, w2[4 * k4 + 3], r2b);
        if ((k4 & 3) == 3) __builtin_amdgcn_sched_barrier(0);
      }
      const float ra = r2a[0] + r2b[0], rx = r2a[1] + r2b[1];
      const float rg = __frcp_rn(1.0f + __expf(-ra));
      const float ig = __frcp_rn(1.0f + __expf(-rx));
      const float la = -8.0f * rg * sp;
      const float a = __expf(la);
      const float xq = -2.0f * la;
      const float om = (xq < 0.25f) ? xq * (1.0f - xq * (0.5f - xq * (0.16666667f - xq * (0.041666668f - xq * 0.0083333338f))))
                                    : (1.0f - __expf(-xq));
      const float bq = __builtin_amdgcn_sqrtf(om) * (ig * uc);
      if (MODE == 0) {
        const u16 bqb = f2bf(bq);
        aout[(t8 * 4 + i) * 512] = a;
        p.hb[(tok0 + t8 * 4 + i) * LDH + c] = bqb;
        hst = a * hst + bf1(bqb);
      } else {
        hst = a * hst + bq;
      }
      if (MODE == 0) Ac *= a;
      if (MODE == 1) {
        const float g = gbat[i];
        const float ge = 0.5f * g * (1.0f + tanhf(0.7978845608028654f * (g + 0.044715f * g * g * g)));
        p.hb[(tok0 + t8 * 4 + i) * LDH + c] = f2bf(hst * ge);
      }
    }
  }
  if (MODE == 0) {
    float2 ah; ah.x = Ac; ah.y = hst;
    *(float2*)(p.agg + ((long)r * 512 + c) * 2) = ah;
  }
  __syncthreads();
}

__device__ void lru_gate_tile(const Params& p, int L, int r) {
  extern __shared__ __attribute__((aligned(16))) char smem[];
  const int w = wave_l(), lane = lane_l(), fr = lane & 15, fq = lane >> 4;
  const int jl = L >> 1, c = w * 64 + lane;
  char* wl = smem + w * 11264;
  char* U = wl;
  float* Ga = (float*)(wl + 2304);
  float* Gx = (float*)(wl + 2304 + 4352);
  bf16x8 wfa[4][2], wfx[4][2];
  {
    const float* ga = p.od_ga_w + (long)jl * 32768 + w * 4096;
    const float* gx = p.od_gx_w + (long)jl * 32768 + w * 4096;
#pragma unroll
    for (int dt = 0; dt < 4; ++dt)
#pragma unroll
      for (int ks = 0; ks < 2; ++ks) {
        const int k0 = ks * 32 + fq * 8, d = dt * 16 + fr;
        unsigned a4[4], x4[4];
#pragma unroll
        for (int j = 0; j < 4; ++j) {
          a4[j] = pack2(ga[(k0 + 2 * j) * 64 + d], ga[(k0 + 2 * j + 1) * 64 + d]);
          x4[j] = pack2(gx[(k0 + 2 * j) * 64 + d], gx[(k0 + 2 * j + 1) * 64 + d]);
        }
        typedef unsigned u32x4_ __attribute__((ext_vector_type(4)));
        wfa[dt][ks] = __builtin_bit_cast(bf16x8, (u32x4_){a4[0], a4[1], a4[2], a4[3]});
        wfx[dt][ks] = __builtin_bit_cast(bf16x8, (u32x4_){x4[0], x4[1], x4[2], x4[3]});
      }
  }
  const float cw0 = p.od_conv_w[jl * 2048 + c], cw1 = p.od_conv_w[jl * 2048 + 512 + c];
  const float cw2 = p.od_conv_w[jl * 2048 + 1024 + c], cw3 = p.od_conv_w[jl * 2048 + 1536 + c];
  const float cb = p.od_conv_b[jl * 512 + c], ba = p.od_ga_b[jl * 512 + c], bx = p.od_gx_b[jl * 512 + c];
  const float lam = p.od_lam[jl * 512 + c];
  const float sp = (lam > 15.f) ? __expf(-lam) : log1pf(__expf(-lam));
  const int pos0 = (r & 15) * 256;
  const long tok0 = (long)r * 256;
  const u16* zu = p.z + 512 + c;
  float u1 = 0.f, u2 = 0.f, u3 = 0.f;
  if (pos0 > 0) { u1 = bf1(zu[(tok0 - 1) * ZW]); u2 = bf1(zu[(tok0 - 2) * ZW]); u3 = bf1(zu[(tok0 - 3) * ZW]); }
  float hst = 0.f, Ac = 1.f;
  float* aout = (float*)((char*)(p.hid + (long)r * SLAB_ELEMS) + 786432) + c;
  u16 unext[16];
#pragma unroll
  for (int i = 0; i < 16; ++i) unext[i] = zu[(tok0 + i) * ZW];
  for (int g16 = 0; g16 < 16; ++g16) {
    float ucv[16];
#pragma unroll
    for (int i = 0; i < 16; ++i) {
      const float u0 = bf1(unext[i]);
      ucv[i] = cw0 * u3 + cw1 * u2 + cw2 * u1 + cw3 * u0 + cb;
      u3 = u2; u2 = u1; u1 = u0;
      *(u16*)(U + i * 144 + lane * 2) = f2bf(ucv[i]);
    }
    if (g16 < 15) {
#pragma unroll
      for (int i = 0; i < 16; ++i) unext[i] = zu[(tok0 + (g16 + 1) * 16 + i) * ZW];
    }
    const bf16x8 uf0 = *(const bf16x8*)(U + fr * 144 + (fq * 8) * 2);
    const bf16x8 uf1 = *(const bf16x8*)(U + fr * 144 + (32 + fq * 8) * 2);
#pragma unroll
    for (int dt = 0; dt < 4; ++dt) {
      f32x4 da = (f32x4){0.f, 0.f, 0.f, 0.f}, dx = (f32x4){0.f, 0.f, 0.f, 0.f};
      da = mfma16(wfa[dt][0], uf0, da); da = mfma16(wfa[dt][1], uf1, da);
      dx = mfma16(wfx[dt][0], uf0, dx); dx = mfma16(wfx[dt][1], uf1, dx);
      *(float4*)(Ga + fr * 68 + dt * 16 + fq * 4) = make_float4(da[0], da[1], da[2], da[3]);
      *(float4*)(Gx + fr * 68 + dt * 16 + fq * 4) = make_float4(dx[0], dx[1], dx[2], dx[3]);
    }
#pragma unroll
    for (int i = 0; i < 16; ++i) {
      const float uc = ucv[i];
      const float ra = Ga[i * 68 + lane] + ba, rx = Gx[i * 68 + lane] + bx;
      const float rg = __frcp_rn(1.0f + __expf(-ra));
      const float ig = __frcp_rn(1.0f + __expf(-rx));
      const float la = -8.0f * rg * sp;
      const float a = __expf(la);
      const float xq = -2.0f * la;
      const float om = (xq < 0.25f) ? xq * (1.0f - xq * (0.5f - xq * (0.16666667f - xq * (0.041666668f - xq * 0.0083333338f))))
                                    : (1.0f - __expf(-xq));
      const float bq = __builtin_amdgcn_sqrtf(om) * (ig * uc);
      const u16 bqb = f2bf(bq);
      aout[(g16 * 16 + i) * 512] = a;
      p.hb[(tok0 + g16 * 16 + i) * LDH + c] = bqb;
      hst = a * hst + bf1(bqb);
      Ac *= a;
    }
  }
  float2 ah; ah.x = Ac; ah.y = hst;
  *(float2*)(p.agg + ((long)r * 512 + c) * 2) = ah;
  __syncthreads();
}

__device__ __forceinline__ void attn_decode(const int item, int& pat, int& h, int& dil, int& blk, long& tokb) {
  pat = item >> 11;
  const int q0 = item & 2047, b = q0 >> 7, q2 = q0 & 127, s = q2 & 31;
  h = q2 >> 5;
  dil = (pat == 0) ? 1 : (pat == 1 ? 4 : 16);
  const int nblk = 32 / dil;
  const int rr = s / nblk;
  blk = s % nblk;
  tokb = (long)b * SEQ + rr;
}

__device__ void attn_items(const Params& p, const int item0, const int nitems) {
  extern __shared__ __attribute__((aligned(16))) char smem[];
  const int w = wave_l(), lane = lane_l(), tid = w * 64 + lane, fr = lane & 15, fq = lane >> 4;
  char* KVs = smem;
  char* Qs = smem + 69632;
  char* Ps = smem + 69632;
  const int lrow = tid >> 4, lch = tid & 15;
  uint4 qr0, qr1, qr2, qr3, kr[8], vr[8];
  int pat, h, dil, blk; long tokb;
  if (nitems > 0) {
    attn_decode(item0, pat, h, dil, blk, tokb);
#define QLD(dst, j, TB, DL, BK, HH) dst = *(const uint4*)(p.z + ((TB) + (long)(DL) * (128 * (BK) + lrow + 32 * (j))) * ZW + 1024 + (HH) * 128 + lch * 8)
    QLD(qr0, 0, tokb, dil, blk, h); QLD(qr1, 1, tokb, dil, blk, h); QLD(qr2, 2, tokb, dil, blk, h); QLD(qr3, 3, tokb, dil, blk, h);
#pragma unroll
    for (int j = 0; j < 8; ++j) {
      const int row = lrow + 32 * j;
      kr[j] = make_uint4(0u, 0u, 0u, 0u);
      if (blk > 0 || row >= 128) {
        const long tok = tokb + (long)dil * (128 * (blk - 1) + row);
        kr[j] = *(const uint4*)(p.z + tok * ZW + 1536 + h * 128 + lch * 8);
      }
    }
  }
  for (int n = 0; n < nitems; ++n) {
    attn_decode(item0 + n, pat, h, dil, blk, tokb);
    *(uint4*)(Qs + (lrow + 0) * 272 + lch * 16) = qr0; *(uint4*)(Qs + (lrow + 32) * 272 + lch * 16) = qr1;
    *(uint4*)(Qs + (lrow + 64) * 272 + lch * 16) = qr2; *(uint4*)(Qs + (lrow + 96) * 272 + lch * 16) = qr3;
#pragma unroll
    for (int j = 0; j < 8; ++j) *(uint4*)(KVs + (lrow + 32 * j) * 272 + lch * 16) = kr[j];
#pragma unroll
    for (int j = 0; j < 8; ++j) {
      const int row = lrow + 32 * j;
      vr[j] = make_uint4(0u, 0u, 0u, 0u);
      if (blk > 0 || row >= 128) {
        const long tok = tokb + (long)dil * (128 * (blk - 1) + row);
        vr[j] = *(const uint4*)(p.z + tok * ZW + 2048 + h * 128 + lch * 8);
      }
    }
    __syncthreads();
    bf16x8 qf[4];
#pragma unroll
    for (int ks = 0; ks < 4; ++ks) qf[ks] = *(const bf16x8*)(Qs + (w * 16 + fr) * 272 + (ks * 32 + fq * 8) * 2);
    f32x4 sc[9];
    const int i = w * 16 + fr;
    float mx = -3.0e38f;
#pragma unroll
    for (int tt = 0; tt < 9; ++tt) {
      const int kt = w + tt;
      f32x4 a = (f32x4){0.f, 0.f, 0.f, 0.f};
#pragma unroll
      for (int ks = 0; ks < 4; ++ks) {
        bf16x8 kf = *(const bf16x8*)(KVs + (kt * 16 + fr) * 272 + (ks * 32 + fq * 8) * 2);
        a = mfma16(kf, qf[ks], a);
      }
#pragma unroll
      for (int jj = 0; jj < 4; ++jj) {
        const int kk = kt * 16 + fq * 4 + jj;
        const int rel = i + 128 - kk;
        const bool valid = (rel >= 0) && (rel <= 128) && (blk > 0 || kk >= 128);
        a[jj] = valid ? a[jj] : -3.0e38f;
        mx = fmaxf(mx, a[jj]);
      }
      sc[tt] = a;
    }
    mx = fmaxf(mx, __shfl_xor(mx, 16));
    mx = fmaxf(mx, __shfl_xor(mx, 32));
    float den = 0.f;
#pragma unroll
    for (int tt = 0; tt < 9; ++tt)
#pragma unroll
      for (int jj = 0; jj < 4; ++jj) {
        const float e = (sc[tt][jj] > -1.0e38f) ? __expf(sc[tt][jj] - mx) : 0.f;
        sc[tt][jj] = e; den += e;
      }
    den += __shfl_xor(den, 16);
    den += __shfl_xor(den, 32);
    __syncthreads();
    for (int c = lane; c < 528; c += 64) *(uint4*)(Ps + w * 16 * 528 + c * 16) = make_uint4(0u, 0u, 0u, 0u);
#pragma unroll
    for (int tt = 0; tt < 9; ++tt) {
      uint2 pv; pv.x = pack2(sc[tt][0], sc[tt][1]); pv.y = pack2(sc[tt][2], sc[tt][3]);
      *(uint2*)(Ps + (w * 16 + fr) * 528 + ((w + tt) * 16 + fq * 4) * 2) = pv;
    }
#pragma unroll
    for (int j = 0; j < 8; ++j) *(uint4*)(KVs + (lrow + 32 * j) * 272 + lch * 16) = vr[j];
    if (n + 1 < nitems) {
      int pat2, h2, dil2, blk2; long tokb2;
      attn_decode(item0 + n + 1, pat2, h2, dil2, blk2, tokb2);
      QLD(qr0, 0, tokb2, dil2, blk2, h2); QLD(qr1, 1, tokb2, dil2, blk2, h2); QLD(qr2, 2, tokb2, dil2, blk2, h2); QLD(qr3, 3, tokb2, dil2, blk2, h2);
#pragma unroll
      for (int j = 0; j < 8; ++j) {
        const int row = lrow + 32 * j;
        kr[j] = make_uint4(0u, 0u, 0u, 0u);
        if (blk2 > 0 || row >= 128) {
          const long tok = tokb2 + (long)dil2 * (128 * (blk2 - 1) + row);
          kr[j] = *(const uint4*)(p.z + tok * ZW + 1536 + h2 * 128 + lch * 8);
        }
      }
    }
    __syncthreads();
    f32x4 oacc[8];
#pragma unroll
    for (int et = 0; et < 8; ++et) oacc[et] = (f32x4){0.f, 0.f, 0.f, 0.f};
    const int ks_lo = w >> 1, ks_hi = (16 * w + 143) >> 5;
    for (int ks = ks_lo; ks <= ks_hi; ++ks) {
      bf16x8 pf = *(const bf16x8*)(Ps + (w * 16 + fr) * 528 + (ks * 32 + fq * 8) * 2);
#pragma unroll
      for (int et = 0; et < 8; ++et) {
        bf16x8 vf = trfrag(KVs, 272, ks, et, lane);
        oacc[et] = mfma16(vf, pf, oacc[et]);
      }
    }
    {
      const float inv = 1.0f / den;
      const long tok = tokb + (long)dil * (128 * blk + i);
      u16* op = p.hid + (tok >> 8) * SLAB_ELEMS + (long)pat * (256 * 512) + (tok & 255) * 512 + h * 128 + fq * 4;
#pragma unroll
      for (int et = 0; et < 8; ++et) {
        uint2 ov; ov.x = pack2(oacc[et][0] * inv, oacc[et][1] * inv); ov.y = pack2(oacc[et][2] * inv, oacc[et][3] * inv);
        *(uint2*)(op + et * 16) = ov;
      }
      if (fq == 0) p.lse[((long)pat * NTOK + tok) * 4 + h] = mx + __logf(den);
    }
    __syncthreads();
  }
}

__device__ void lru_final(const Params& p, int L, int r) {
  const int w = wave_l(), lane = lane_l(), c = w * 64 + lane;
  const long tok0 = (long)r * 256;
  const int ti = r & 15;
  float hst = 0.f;
  for (int tt = 0; tt < ti; ++tt) {
    const float2 ah = *(const float2*)(p.agg + ((long)(r - ti + tt) * 512 + c) * 2);
    hst = ah.x * hst + ah.y;
  }
  const float* ap = (const float*)((const char*)(p.hid + (long)r * SLAB_ELEMS) + 786432) + c;
  u16* bp = p.hb + tok0 * LDH + c;
  const u16* gp = p.z + tok0 * ZW + c;
  for (int t8 = 0; t8 < 32; ++t8) {
    float av[8], bv[8], gv[8];
#pragma unroll
    for (int i = 0; i < 8; ++i) {
      av[i] = ap[(t8 * 8 + i) * 512];
      bv[i] = bf1(bp[(long)(t8 * 8 + i) * LDH]);
      gv[i] = bf1(gp[(long)(t8 * 8 + i) * ZW]);
    }
#pragma unroll
    for (int i = 0; i < 8; ++i) {
      hst = av[i] * hst + bv[i];
      const float g = gv[i];
      const float ge = 0.5f * g * (1.0f + tanhf(0.7978845608028654f * (g + 0.044715f * g * g * g)));
      bp[(long)(t8 * 8 + i) * LDH] = f2bf(hst * ge);
    }
  }
  __syncthreads();
}

__device__ void finalize_odd(const Params& p, int L, int r) {
  lru_final(p, L, r);
  const int w = wave_l(), lane = lane_l(), tid = w * 64 + lane;
  const u16* slab = p.hid + (long)r * SLAB_ELEMS;
  u16* cat = p.hb;
  const int head = lane >> 4;
  for (int rr = w; rr < 256; rr += 8) {
    const long tok = (long)r * 256 + rr;
    const float l0 = p.lse[(0L * NTOK + tok) * 4 + head];
    const float l1 = p.lse[(1L * NTOK + tok) * 4 + head];
    const float l2 = p.lse[(2L * NTOK + tok) * 4 + head];
    const float m = fmaxf(l0, fmaxf(l1, l2));
    float e0 = __expf(l0 - m), e1 = __expf(l1 - m), e2 = __expf(l2 - m);
    const float inv = 1.0f / (e0 + e1 + e2);
    e0 *= inv; e1 *= inv; e2 *= inv;
    uint4 a = *(const uint4*)(slab + 0L * (256 * 512) + rr * 512 + lane * 8);
    uint4 bq = *(const uint4*)(slab + 1L * (256 * 512) + rr * 512 + lane * 8);
    uint4 cq = *(const uint4*)(slab + 2L * (256 * 512) + rr * 512 + lane * 8);
    uint4 ov;
    ov.x = pack2(e0 * bflo(a.x) + e1 * bflo(bq.x) + e2 * bflo(cq.x), e0 * bfhi(a.x) + e1 * bfhi(bq.x) + e2 * bfhi(cq.x));
    ov.y = pack2(e0 * bflo(a.y) + e1 * bflo(bq.y) + e2 * bflo(cq.y), e0 * bfhi(a.y) + e1 * bfhi(bq.y) + e2 * bfhi(cq.y));
    ov.z = pack2(e0 * bflo(a.z) + e1 * bflo(bq.z) + e2 * bflo(cq.z), e0 * bfhi(a.z) + e1 * bfhi(bq.z) + e2 * bfhi(cq.z));
    ov.w = pack2(e0 * bflo(a.w) + e1 * bflo(bq.w) + e2 * bflo(cq.w), e0 * bfhi(a.w) + e1 * bfhi(bq.w) + e2 * bfhi(cq.w));
    *(uint4*)(cat + tok * LDH + 512 + lane * 8) = ov;
  }
  __syncthreads();
}

template <int K, int epi>
__device__ void gemm_phase(const Params& p, const u16* A, const u16* Bt, const int nN, const int Lw, const float* res, const u16* resb, u16* ydst, const int lnidx) {
  const int nM = NTILE, nwg = nM * nN, G = gridDim.x, c = blockIdx.x;
  for (int i = 0;; ++i) {
    const long Lq = (long)i * G + c;
    if (Lq >= nwg) break;
    int wgid = (int)Lq;
    {
      const int q = nwg / 8, r = nwg % 8, xcd = wgid % 8, off = wgid / 8;
      wgid = (xcd < r ? xcd * (q + 1) : r * (q + 1) + (xcd - r) * q) + off;
    }
    const int nig = 8 * nN, gid = wgid / nig, fm = gid * 8, gsz = (nM - fm) < 8 ? (nM - fm) : 8;
    const int pm = fm + ((wgid % nig) % gsz), pn = (wgid % nig) / gsz;
    EpiArgs ea;
    ea.row0 = pm * 256; ea.mode = 0; ea.z = p.z; ea.rope = p.rope; ea.res = res; ea.resb = resb; ea.yb = ydst;
    ea.hid = p.hid + (long)pm * SLAB_ELEMS;
    ea.stats = p.stats; ea.lnmode = (lnidx >= 0) ? 1 : 0;
    ea.lng = p.ln_g + (lnidx >= 0 ? lnidx : 0) * DM; ea.lnb = p.ln_b + (lnidx >= 0 ? lnidx : 0) * DM;
    if (epi == EPI_IN) {
      if (Lw & 1) ea.mode = (pn >= 4 && pn < 6) ? 2 : ((pn >= 6 && pn < 8) ? 1 : 0);
      else ea.mode = (pn < 2) ? 2 : (pn < 4 ? 1 : 0);
    }
    gemm_tile<K, epi>(A, Bt, pm * 256, pn * 256, ea);
  }
  __syncthreads();
}

#define XB_TMO      128
#define XB_XCNT(j)  (256  + 64 * (j))
#define XB_XSUB(j)  (1280 + 64 * (j))
#define XB_XGEN(j)  (2304 + 64 * (j))
#define XB_TOP      3328
#define XB_TOPGEN   3392
#define XCD_BAR_WORDS 3456
#define XB_SPIN_CAP (1u << 18)
__device__ __forceinline__ unsigned xb_ld(unsigned* p)              { return __hip_atomic_load(p, __ATOMIC_RELAXED, __HIP_MEMORY_SCOPE_AGENT); }
__device__ __forceinline__ unsigned xb_add(unsigned* p, unsigned v) { return __hip_atomic_fetch_add(p, v, __ATOMIC_RELAXED, __HIP_MEMORY_SCOPE_AGENT); }
__device__ __forceinline__ unsigned xb_xcc_id() { return (unsigned)__builtin_amdgcn_s_getreg((3 << 11) | 20) & 0xFu; }
#define XB_SPIN(cond, bar) do { unsigned _sp = 0; while (cond) { __builtin_amdgcn_s_sleep(1); \
    if ((++_sp & 255u) == 0u) { if (xb_ld(&(bar)[XB_TMO])) break; if (_sp > XB_SPIN_CAP) { atomicAdd(&(bar)[XB_TMO], 1u); break; } } } } while (0)

__device__ __forceinline__ void xcd_barrier(unsigned* bar, const unsigned x, const unsigned nloc, const unsigned nx) {
  asm volatile("s_waitcnt vmcnt(0)" ::: "memory");
  __syncthreads();
  if (threadIdx.x == 0) {
    __builtin_amdgcn_s_waitcnt(0);
    const unsigned old = xb_add(&bar[XB_XSUB(x)], 1u);
    const unsigned gen = old / nloc;
    if (old + 1u == (gen + 1u) * nloc) {
      __builtin_amdgcn_fence(__ATOMIC_RELEASE, "agent");
      asm volatile("s_waitcnt vmcnt(0)" ::: "memory");
      const unsigned og = xb_add(&bar[XB_TOP], 1u);
      const unsigned tg = og / nx;
      if (og + 1u == (tg + 1u) * nx) xb_add(&bar[XB_TOPGEN], 1u);
      else XB_SPIN(xb_ld(&bar[XB_TOPGEN]) == tg, bar);
      __builtin_amdgcn_fence(__ATOMIC_ACQUIRE, "agent");
      xb_add(&bar[XB_XGEN(x)], 1u);
      asm volatile("s_waitcnt vmcnt(0)" ::: "memory");
    } else {
      XB_SPIN(xb_ld(&bar[XB_XGEN(x)]) == gen, bar);
      __builtin_amdgcn_fence(__ATOMIC_ACQUIRE, "agent");
      asm volatile("s_waitcnt vmcnt(0)" ::: "memory");
    }
  }
  __syncthreads();
}

#ifndef DUP_GEMM
#define DUP_GEMM 0
#endif
__global__ void __launch_bounds__(512) mega(Params p, int ph0, int ph1) {
  cg::grid_group grid = cg::this_grid();
  unsigned* bar = p.bar;
  const unsigned myx = xb_xcc_id();
  unsigned nloc = 1u, nx = 1u;
  if (threadIdx.x == 0) (void)xb_add(&bar[XB_XCNT(myx)], 1u);
  for (int ph = ph0; ph < ph1; ++ph) {
    if (ph == 0) {
      phase0(p);
    } else {
      const int L = (ph - 1) >> 3, k = (ph - 1) & 7;
      u16* ybm = (u16*)p.hf;
      const u16* wl = p.wbf + (long)L * W_PER_LAYER;
      if (k == 0) {
        for (int rep = 0; rep <= DUP_GEMM; ++rep) gemm_phase<DM, EPI_IN>(p, p.hb, wl + WOFF_IN, 10, L, p.x, ybm, ybm, -1);
      } else if (k == 1) {
        if (L & 1) {
          for (int it = blockIdx.x; it < 256; it += gridDim.x) lru_gate_tile(p, L, it);
          const int i0 = (int)((long)blockIdx.x * 6144 / gridDim.x), i1 = (int)((long)(blockIdx.x + 1) * 6144 / gridDim.x);
          attn_items(p, i0, i1 - i0);
        } else {
          for (int it = blockIdx.x; it < 256; it += gridDim.x) retention_item(p, it);
        }
      } else if (k == 2) {
        for (int r = blockIdx.x; r < NTILE; r += gridDim.x) {
          if (L & 1) finalize_odd(p, L, r); else finalize_even(p, L, r);
        }
      } else if (k == 3) {
        for (int rep = 0; rep <= DUP_GEMM; ++rep) gemm_phase<DM, EPI_RES>(p, p.hb, wl + WOFF_OUT, 4, L, p.x, ybm, ybm, (L == 0) ? -1 : (L - 1) * 2 + 1);
      } else if (k == 4 || k == 7) {
        const int which = (k == 4) ? 0 : 1;
        for (int r = blockIdx.x; r < NTILE; r += gridDim.x)
          ln_rows((L == 3 && which == 1) ? (const u16*)p.z : ybm, p.hf, p.hb, (long)r * 256, p.ln_g + (L * 2 + which) * DM, p.ln_b + (L * 2 + which) * DM, p.stats, (L == 3 && which == 1));
      } else if (k == 5) {
        for (int rep = 0; rep <= DUP_GEMM; ++rep) gemm_phase<DM, EPI_SWIGLU>(p, p.hb, wl + WOFF_FI, 22, L, p.x, ybm, ybm, -1);
      } else {
        for (int rep = 0; rep <= DUP_GEMM; ++rep) gemm_phase<DFF, EPI_RES>(p, p.hid, wl + WOFF_FO, 4, L, p.x, ybm, (L == 3) ? p.z : ybm, L * 2);
      }
    }
    if (ph + 1 < ph1) {
      if (ph == ph0) {
        grid.sync();
        unsigned cnt = 0u, mine = 0u;
#pragma unroll
        for (unsigned j = 0; j < 16; ++j) { const unsigned c = xb_ld(&bar[XB_XCNT(j)]); cnt += (c > 0u) ? 1u : 0u; mine = (j == myx) ? c : mine; }
        nloc = (unsigned)__builtin_amdgcn_readfirstlane(mine > 0u ? mine : 1u);
        nx = (unsigned)__builtin_amdgcn_readfirstlane(cnt > 0u ? cnt : 1u);
      } else {
        xcd_barrier(bar, myx, nloc, nx);
      }
    }
  }
}

extern "C" void kernel_launch(void* const* d_in, const int* in_sizes, int n_in, void* d_out, int out_size,
                              void* d_ws, size_t ws_size, hipStream_t stream) {
  Params p{};
  p.x = (const float*)d_in[0]; p.pos = (const int*)d_in[1];
  p.ev_w_in = (const float*)d_in[2]; p.ev_norm_g = (const float*)d_in[3]; p.ev_pool_w = (const float*)d_in[4];
  p.ev_pool_scale = (const float*)d_in[5]; p.ev_w_out = (const float*)d_in[6];
  p.od_w_in = (const float*)d_in[7]; p.od_conv_w = (const float*)d_in[8]; p.od_conv_b = (const float*)d_in[9];
  p.od_ga_w = (const float*)d_in[10]; p.od_ga_b = (const float*)d_in[11]; p.od_gx_w = (const float*)d_in[12];
  p.od_gx_b = (const float*)d_in[13]; p.od_lam = (const float*)d_in[14]; p.od_w_out = (const float*)d_in[15];
  p.ffn_w_in = (const float*)d_in[16]; p.ffn_w_out = (const float*)d_in[17];
  p.ln_g = (const float*)d_in[18]; p.ln_b = (const float*)d_in[19];
  p.hf = (float*)d_out;
  char* ws = (char*)d_ws;
  size_t off = 0;
  p.wbf = (u16*)(ws + off); off += (size_t)4 * W_PER_LAYER * 2;
  p.poolwt = (u16*)(ws + off); off += (size_t)8 * 16384 * 2;
  p.rope = (float*)(ws + off); off += (size_t)NTOK * 128 * 4;
  p.hb = (u16*)(ws + off); off += (size_t)NTOK * LDH * 2;
  p.z = (u16*)(ws + off); off += (size_t)NTOK * ZW * 2;
  p.hid = (u16*)(ws + off); off += (size_t)NTOK * LDHID * 2;
  p.lse = (float*)(ws + off); off += (size_t)3 * NTOK * 4 * 4;
  p.agg = (float*)(ws + off); off += (size_t)NTILE * 512 * 2 * 4;
  p.stats = (float*)(ws + off); off += (size_t)NTOK * 2 * 4;
  p.bar = (unsigned*)(ws + off); off += (size_t)XCD_BAR_WORDS * 4;
  if (off > ws_size) { fprintf(stderr, "workspace too small: need %zu have %zu\n", off, ws_size); return; }
  (void)hipFuncSetAttribute((const void*)mega, hipFuncAttributeMaxDynamicSharedMemorySize, DYN_LDS);
  static int grid_blocks = 0;
  if (!grid_blocks) {
    int dev = 0, cus = 0, per_cu = 0;
    (void)hipGetDevice(&dev);
    (void)hipDeviceGetAttribute(&cus, hipDeviceAttributeMultiprocessorCount, dev);
    (void)hipOccupancyMaxActiveBlocksPerMultiprocessor(&per_cu, mega, 512, DYN_LDS);
    if (per_cu < 1) per_cu = 1;
    grid_blocks = cus * per_cu;
    if (grid_blocks > 256) grid_blocks = 256;
  }
  (void)hipMemsetAsync(p.bar, 0, (size_t)XCD_BAR_WORDS * 4, stream);
  int ph0 = 0, ph1 = 33;
  void* args[] = {&p, &ph0, &ph1};
  hipError_t e = hipLaunchCooperativeKernel((const void*)mega, dim3(grid_blocks), dim3(512), args, DYN_LDS, stream);
  if (e != hipSuccess) fprintf(stderr, "cooperative launch failed: %s (grid %d)\n", hipGetErrorString(e), grid_blocks);
}
```

```cpp
#include <hip/hip_runtime.h>
#include <hip/hip_cooperative_groups.h>
#include <math.h>
#include <cstdio>
namespace cg = cooperative_groups;

typedef unsigned short u16;
typedef short bf16x8 __attribute__((ext_vector_type(8)));
typedef short s16x4 __attribute__((ext_vector_type(4)));
typedef float f32x4 __attribute__((ext_vector_type(4)));

#define NTOK 65536
#define SEQ 4096
#define DM 1024
#define ZW 2624
#define ZN 2560
#define LDH 1088
#define LDHID 2880
#define DFF 2816
#define NTILE 256
#define DYN_LDS 139264
#define ALPHA 1.681792830507429f
#define QSCALE 0.08838834764831845f
#define LN_EPS 1e-5f

#define WOFF_IN 0L
#define WOFF_OUT 2785280L
#define WOFF_FI 3899392L
#define WOFF_FO 10027008L
#define W_PER_LAYER 12976128L
#define SLAB_ELEMS (256L * 2880L)

struct Params {
  const float* x; const int* pos;
  const float* ev_w_in; const float* ev_norm_g; const float* ev_pool_w; const float* ev_pool_scale; const float* ev_w_out;
  const float* od_w_in; const float* od_conv_w; const float* od_conv_b; const float* od_ga_w; const float* od_ga_b;
  const float* od_gx_w; const float* od_gx_b; const float* od_lam; const float* od_w_out;
  const float* ffn_w_in; const float* ffn_w_out; const float* ln_g; const float* ln_b;
  float* hf;
  u16* wbf; u16* poolwt; float* rope; u16* hb; u16* z; u16* hid; float* lse; float* agg; float* stats; unsigned* bar;
};

typedef __bf16 hbf16x2 __attribute__((ext_vector_type(2)));
typedef float hf32x2 __attribute__((ext_vector_type(2)));
__device__ __forceinline__ unsigned pack2(float a, float b) {
  hf32x2 v = {a, b};
  hbf16x2 r = __builtin_convertvector(v, hbf16x2);
  return __builtin_bit_cast(unsigned, r);
}
typedef _Float16 hf16x2 __attribute__((ext_vector_type(2)));
__device__ __forceinline__ unsigned pack2h(float a, float b) {
  hf32x2 v = {a, b};
  hf16x2 r = __builtin_convertvector(v, hf16x2);
  return __builtin_bit_cast(unsigned, r);
}
__device__ __forceinline__ float hlo(unsigned u) { return (float)__builtin_bit_cast(hf16x2, u)[0]; }
__device__ __forceinline__ float hhi(unsigned u) { return (float)__builtin_bit_cast(hf16x2, u)[1]; }
__device__ __forceinline__ u16 f2bf(float f) { return (u16)(pack2(f, 0.f) & 0xffffu); }
__device__ __forceinline__ float bflo(unsigned u) { return __uint_as_float(u << 16); }
__device__ __forceinline__ float bfhi(unsigned u) { return __uint_as_float(u & 0xffff0000u); }
__device__ __forceinline__ float bf1(u16 h) { return __uint_as_float(((unsigned)h) << 16); }
__device__ __forceinline__ f32x4 mfma16(bf16x8 x, bf16x8 y, f32x4 c) { return __builtin_amdgcn_mfma_f32_16x16x32_bf16(x, y, c, 0, 0, 0); }

__device__ __forceinline__ long hbt_off(const long tok, const int col) {
  const int r = (int)(tok & 255);
  return (tok >> 8) * 524288L + (long)(col >> 5) * 16384 + r * 64 + ((((col >> 3) & 3) ^ ((0 - (r >> 2)) & 3)) << 4) + (col & 7) * 2;
}

__device__ __forceinline__ int lane_l() { int t = threadIdx.x & 63; asm volatile("" : "+v"(t)); return t; }
__device__ __forceinline__ int wave_l() { int w = __builtin_amdgcn_readfirstlane(threadIdx.x >> 6); asm volatile("" : "+s"(w)); return w; }

__device__ __forceinline__ bf16x8 trfrag(const char* base, int RS, int ks, int c, int lane) {
  const int g = lane >> 4, q = (lane & 15) >> 2, pp = lane & 3;
  const char* a0 = base + (32 * ks + 8 * g + q) * RS + (16 * c + 4 * pp) * 2;
  s16x4 v0 = __builtin_amdgcn_ds_read_tr16_b64_v4i16((__attribute__((address_space(3))) s16x4*)(a0));
  s16x4 v1 = __builtin_amdgcn_ds_read_tr16_b64_v4i16((__attribute__((address_space(3))) s16x4*)(a0 + 4 * RS));
  bf16x8 r;
  r[0] = v0[0]; r[1] = v0[1]; r[2] = v0[2]; r[3] = v0[3];
  r[4] = v1[0]; r[5] = v1[1]; r[6] = v1[2]; r[7] = v1[3];
  return r;
}

constexpr int BM = 256, BK = 64, HALF = 128, HT = HALF * BK;

__device__ __forceinline__ int lds_byte(int r, int c) {
  int st = (r >> 4) * 2 + (c >> 5), rr = r & 15, cc = c & 31, ob = rr * 64 + cc * 2;
  return st * 1024 + (ob ^ (((ob >> 9) & 1) << 5));
}
__device__ __forceinline__ void stage_rc(int b, int& R, int& C) {
  int st = b / 1024, sb = b % 1024, swz = sb ^ (((sb >> 9) & 1) << 5);
  R = (st >> 1) * 16 + swz / 64; C = (st & 1) * 32 + (swz % 64) / 2;
}

enum { EPI_IN = 0, EPI_RES = 1, EPI_SWIGLU = 2 };
struct EpiArgs {
  int row0;
  int mode;
  u16* z; const float* rope;
  const float* res; const u16* resb; u16* yb;
  u16* hid;
  const float* stats; const float* lng; const float* lnb; int lnmode;
};

template <int K, int epi>
__device__ __forceinline__ void gemm_tile(const u16* __restrict__ A, const u16* __restrict__ Bt,
                                          const int brow, const int bcol, const EpiArgs ea) {
  extern __shared__ __attribute__((aligned(16))) char smem[];
  const int wid = wave_l(), lane = lane_l(), tid = wid * 64 + lane, wr = wid >> 2, wc = wid & 3, fr = lane & 15, fq = lane >> 4;
  constexpr int LDK = K + 64;
  const unsigned soff = (unsigned)((tid >> 2) * LDK + (((tid & 3) ^ ((0 - (tid >> 4)) & 3)) * 8));
  constexpr bool TA = (K == DFF) || (epi != EPI_RES);
  constexpr long ATILE = (K == DFF) ? SLAB_ELEMS : 262144L;
  const u16* ga = TA ? (A + (long)(brow >> 8) * ATILE + tid * 8) : (A + (long)brow * LDK + soff);
  const u16* gb = Bt + (long)(bcol >> 8) * (K / 32) * 8192 + tid * 8;
#define ISSUE(kt) do { \
    char* _l = smem + ((kt) & 3) * 32768 + tid * 16; \
    __builtin_amdgcn_global_load_lds((const unsigned*)(ga + (TA ? (kt) * 8192 : (kt) * 32)), (unsigned*)(_l), 16, 0, 0); \
    __builtin_amdgcn_global_load_lds((const unsigned*)(ga + (TA ? (kt) * 8192 + 4096 : (kt) * 32 + 128 * LDK)), (unsigned*)(_l + 8192), 16, 0, 0); \
    __builtin_amdgcn_global_load_lds((const unsigned*)(gb + (kt) * 8192), (unsigned*)(_l + 16384), 16, 0, 0); \
    __builtin_amdgcn_global_load_lds((const unsigned*)(gb + (kt) * 8192 + 4096), (unsigned*)(_l + 24576), 16, 0, 0); } while (0)
#define PIECE(kt, j) do { \
    char* _l = smem + ((kt) & 3) * 32768 + tid * 16 + (j) * 8192; \
    const u16* _g = ((j) & 2) ? (gb + (kt) * 8192 + (((j) & 1) ? 4096 : 0)) : (ga + (TA ? ((kt) * 8192 + (((j) & 1) ? 4096 : 0)) : ((kt) * 32 + (((j) & 1) ? 128 * LDK : 0)))); \
    __builtin_amdgcn_global_load_lds((const unsigned*)(_g), (unsigned*)(_l), 16, 0, 0); } while (0)
  f32x4 acc[8][4];
#pragma unroll
  for (int m = 0; m < 8; ++m)
#pragma unroll
    for (int n = 0; n < 4; ++n) acc[m][n] = (f32x4){0.f, 0.f, 0.f, 0.f};
  const int cpos = (fq ^ ((0 - (fr >> 2)) & 3)) * 16;
  const int aoff = (wr * 128 + fr) * 64 + cpos;
  const int boff = 16384 + (wc * 64 + fr) * 64 + cpos;
  constexpr int nt = K / 32;
  if (wr == 1) __builtin_amdgcn_s_setprio(1);
  ISSUE(0); ISSUE(1); ISSUE(2);
  asm volatile("s_waitcnt vmcnt(8)" ::: "memory");
  __builtin_amdgcn_s_barrier();
  bf16x8 B0[4], B1[4], Ac[4], An[4];
#pragma unroll
  for (int n = 0; n < 4; ++n) B0[n] = *reinterpret_cast<const bf16x8*>(smem + boff + n * 1024);
#pragma unroll
  for (int m = 0; m < 4; ++m) Ac[m] = *reinterpret_cast<const bf16x8*>(smem + aoff + m * 1024);
#define SB_ __builtin_amdgcn_sched_barrier(0)
#define MG(mi, Afrag, Bcur) do { _Pragma("unroll") for (int n = 0; n < 4; ++n) \
    acc[mi][n] = __builtin_amdgcn_mfma_f32_16x16x32_bf16(Bcur[n], Afrag, acc[mi][n], 0, 0, 0); } while (0)
#define LDA_(dst, base, mi) dst = *reinterpret_cast<const bf16x8*>((base) + aoff + (mi) * 1024)
#define LDB_(dst, base, ni) dst = *reinterpret_cast<const bf16x8*>((base) + boff + (ni) * 1024)
#define KSTEP(t, Bcur, Bnxt) do { \
    if ((t) + 1 < nt) { \
      if ((t) + 2 < nt) asm volatile("s_waitcnt vmcnt(4)" ::: "memory"); \
      else asm volatile("s_waitcnt vmcnt(0)" ::: "memory"); \
    } \
    __builtin_amdgcn_s_barrier(); \
    const char* _sc = smem + ((t) & 3) * 32768; \
    const char* _sn = smem + (((t) + 1) & 3) * 32768; \
    const bool _iss = (t) + 3 < nt, _pre = (t) + 1 < nt; \
    SB_; MG(0, Ac[0], Bcur); SB_; \
    if (_iss && wr == 0) PIECE((t) + 3, 0); \
    LDA_(An[0], _sc, 4); LDA_(An[1], _sc, 5); \
    SB_; MG(1, Ac[1], Bcur); SB_; \
    if (_iss && wr == 1) PIECE((t) + 3, 0); \
    LDA_(An[2], _sc, 6); LDA_(An[3], _sc, 7); \
    SB_; MG(2, Ac[2], Bcur); SB_; \
    if (_iss && wr == 0) PIECE((t) + 3, 1); \
    if (_pre) { LDB_(Bnxt[0], _sn, 0); LDB_(Bnxt[1], _sn, 1); } \
    SB_; MG(3, Ac[3], Bcur); SB_; \
    if (_iss && wr == 1) PIECE((t) + 3, 1); \
    if (_pre) { LDB_(Bnxt[2], _sn, 2); LDB_(Bnxt[3], _sn, 3); } \
    SB_; MG(4, An[0], Bcur); SB_; \
    if (_iss && wr == 0) PIECE((t) + 3, 2); \
    if (_pre) { LDA_(Ac[0], _sn, 0); LDA_(Ac[1], _sn, 1); } \
    SB_; MG(5, An[1], Bcur); SB_; \
    if (_iss && wr == 1) PIECE((t) + 3, 2); \
    if (_pre) { LDA_(Ac[2], _sn, 2); LDA_(Ac[3], _sn, 3); } \
    SB_; MG(6, An[2], Bcur); SB_; \
    if (_iss && wr == 0) PIECE((t) + 3, 3); \
    SB_; MG(7, An[3], Bcur); SB_; \
    if (_iss && wr == 1) PIECE((t) + 3, 3); \
    SB_; \
  } while (0)
  for (int t = 0; t < nt; t += 2) {
    KSTEP(t, B0, B1);
    KSTEP(t + 1, B1, B0);
  }
#undef KSTEP
  __builtin_amdgcn_s_setprio(0);
#undef MG
#undef LDA_
#undef LDB_
#undef SB_
#undef PIECE
#undef ISSUE
  if (epi == EPI_IN && ea.mode == 0) {
#pragma unroll
    for (int m = 0; m < 8; ++m) {
      const long tok = (long)ea.row0 + wr * 128 + m * 16 + fr;
#pragma unroll
      for (int np = 0; np < 2; ++np) {
        f32x4 a0 = acc[m][2 * np], a1 = acc[m][2 * np + 1];
        uint4 ob;
        ob.x = pack2(a0[0], a0[1]); ob.y = pack2(a0[2], a0[3]); ob.z = pack2(a1[0], a1[1]); ob.w = pack2(a1[2], a1[3]);
        *(uint4*)(ea.z + tok * ZW + bcol + wc * 64 + np * 32 + fq * 8) = ob;
      }
    }
  } else if (epi == EPI_IN) {
#pragma unroll
    for (int m = 0; m < 8; ++m) {
      const int r = wr * 128 + m * 16 + fr;
      const long tok = (long)ea.row0 + r;
      const int d8 = (wc & 1) * 32 + fq * 8;
      const float sc = (ea.mode == 2) ? QSCALE : 1.0f;
      unsigned w1[4], w2[4];
#pragma unroll
      for (int n2 = 0; n2 < 2; ++n2) {
        float4 c01 = make_float4(1.f, 0.f, 1.f, 0.f), c23 = make_float4(1.f, 0.f, 1.f, 0.f);
        if (ea.mode) {
          const float4* cp = (const float4*)(ea.rope + tok * 128 + (d8 + n2 * 4) * 2);
          c01 = cp[0]; c23 = cp[1];
        }
        f32x4 a0 = acc[m][n2], a1 = acc[m][n2 + 2];
        const float cs[4] = {c01.x, c01.z, c23.x, c23.z};
        const float sn[4] = {c01.y, c01.w, c23.y, c23.w};
        float o1[4], o2[4];
#pragma unroll
        for (int j = 0; j < 4; ++j) {
          o1[j] = (a0[j] * cs[j] - a1[j] * sn[j]) * sc;
          o2[j] = (a1[j] * cs[j] + a0[j] * sn[j]) * sc;
        }
        w1[n2 * 2] = pack2(o1[0], o1[1]); w1[n2 * 2 + 1] = pack2(o1[2], o1[3]);
        w2[n2 * 2] = pack2(o2[0], o2[1]); w2[n2 * 2 + 1] = pack2(o2[2], o2[3]);
      }
      u16* zp = ea.z + tok * ZW + bcol + (wc >> 1) * 128 + d8;
      *(uint4*)zp = make_uint4(w1[0], w1[1], w1[2], w1[3]);
      *(uint4*)(zp + 64) = make_uint4(w2[0], w2[1], w2[2], w2[3]);
    }
  } else if (epi == EPI_RES) {
#pragma unroll
    for (int m = 0; m < 8; ++m) {
      const int r = wr * 128 + m * 16 + fr;
      const long tok = (long)ea.row0 + r;
      float mu = 0.f, rstd = 1.f;
      if (ea.lnmode) { const float2 st = *(const float2*)(ea.stats + tok * 2); mu = st.x; rstd = st.y; }
#pragma unroll
      for (int np = 0; np < 2; ++np) {
        const int col = bcol + wc * 64 + np * 32 + fq * 8;
        const long off = tok * DM + col;
        float rv[8];
        if (ea.lnmode) {
          const uint4 rb = *(const uint4*)(ea.resb + off);
          const float4 g0 = *(const float4*)(ea.lng + col), g1 = *(const float4*)(ea.lng + col + 4);
          const float4 b0 = *(const float4*)(ea.lnb + col), b1 = *(const float4*)(ea.lnb + col + 4);
          rv[0] = (hlo(rb.x) - mu) * rstd * g0.x + b0.x; rv[1] = (hhi(rb.x) - mu) * rstd * g0.y + b0.y;
          rv[2] = (hlo(rb.y) - mu) * rstd * g0.z + b0.z; rv[3] = (hhi(rb.y) - mu) * rstd * g0.w + b0.w;
          rv[4] = (hlo(rb.z) - mu) * rstd * g1.x + b1.x; rv[5] = (hhi(rb.z) - mu) * rstd * g1.y + b1.y;
          rv[6] = (hlo(rb.w) - mu) * rstd * g1.z + b1.z; rv[7] = (hhi(rb.w) - mu) * rstd * g1.w + b1.w;
        } else {
          const float4 x0 = *(const float4*)(ea.res + off), x1 = *(const float4*)(ea.res + off + 4);
          rv[0] = x0.x; rv[1] = x0.y; rv[2] = x0.z; rv[3] = x0.w; rv[4] = x1.x; rv[5] = x1.y; rv[6] = x1.z; rv[7] = x1.w;
        }
        f32x4 a0 = acc[m][2 * np], a1 = acc[m][2 * np + 1];
        uint4 ob;
        ob.x = pack2h(ALPHA * rv[0] + a0[0], ALPHA * rv[1] + a0[1]); ob.y = pack2h(ALPHA * rv[2] + a0[2], ALPHA * rv[3] + a0[3]);
        ob.z = pack2h(ALPHA * rv[4] + a1[0], ALPHA * rv[5] + a1[1]); ob.w = pack2h(ALPHA * rv[6] + a1[2], ALPHA * rv[7] + a1[3]);
        *(uint4*)(ea.yb + off) = ob;
      }
    }
  } else {
#pragma unroll
    for (int m = 0; m < 8; ++m) {
      const int r = wr * 128 + m * 16 + fr;
      unsigned wv[4];
#pragma unroll
      for (int n2 = 0; n2 < 2; ++n2) {
        f32x4 g = acc[m][n2], u = acc[m][n2 + 2];
        float o[4];
#pragma unroll
        for (int j = 0; j < 4; ++j) o[j] = g[j] * __frcp_rn(1.0f + __expf(-g[j])) * u[j];
        wv[n2 * 2] = pack2(o[0], o[1]); wv[n2 * 2 + 1] = pack2(o[2], o[3]);
      }
      char* hp = (char*)ea.hid + ((long)((bcol >> 6) + wc) * 16384 + r * 64 + ((fq ^ ((0 - (r >> 2)) & 3)) * 16));
      *(uint4*)hp = make_uint4(wv[0], wv[1], wv[2], wv[3]);
    }
  }
}
__device__ __forceinline__ int perm_src(int s, int perm) {
  if (perm == 0) return s;
  const int t = s >> 8, within = s & 255;
  const int wc = within >> 6, n = (within >> 4) & 3, i = within & 15;
  const int sub = (i >> 2) * 8 + (n & 1) * 4 + (i & 3);
  if (perm == 4) perm = (t < 4) ? 1 : 3;
  if (perm == 5) perm = (t >= 4 && t < 8) ? 1 : 3;
  if (perm == 1) return t * 256 + (wc >> 1) * 128 + (n >> 1) * 64 + (wc & 1) * 32 + sub;
  if (perm == 2) return (n >> 1) * DFF + t * 128 + wc * 32 + sub;
  return t * 256 + wc * 64 + (n >> 1) * 32 + sub;
}

__device__ void conv_weight_tile(const float* __restrict__ W, u16* __restrict__ Bt, int K, int N, int perm, int nb, int kb, int ldb) {
  extern __shared__ __attribute__((aligned(16))) char smem[];
  float* T = (float*)smem;
  const int tid = wave_l() * 64 + lane_l();
  {
    const int nn = tid & 63, kk = tid >> 6;
    const int src = perm_src(nb * 64 + nn, perm);
#pragma unroll
    for (int r = 0; r < 8; ++r) {
      const int k = kk + 8 * r;
      T[nn * 65 + k] = W[(long)(kb * 64 + k) * N + src];
    }
  }
  __syncthreads();
  {
    const int nn = tid >> 3, kc = tid & 7;
    const float* tp = T + nn * 65 + kc * 8;
    uint4 o;
    o.x = pack2(tp[0], tp[1]); o.y = pack2(tp[2], tp[3]); o.z = pack2(tp[4], tp[5]); o.w = pack2(tp[6], tp[7]);
    if (ldb > 0) {
      *(uint4*)(Bt + (long)(nb * 64 + nn) * ldb + kb * 64 + kc * 8) = o;
    } else {
      const int n = nb * 64 + nn, k = kb * 64 + kc * 8;
      const int pn = n >> 8, r = n & 255, kt = k >> 5, c = (k & 31) >> 3;
      const int cp = c ^ ((0 - (r >> 2)) & 3);
      const long boff = ((long)pn * (K >> 5) + kt) * 16384 + r * 64 + cp * 16;
      *(uint4*)((char*)Bt + boff) = o;
    }
  }
  __syncthreads();
}

__constant__ float INV_FREQ[64] = {
  1.000000000e+00f, 8.659643531e-01f, 7.498942018e-01f, 6.493816376e-01f, 5.623413324e-01f, 4.869675338e-01f, 4.216965139e-01f, 3.651741147e-01f, 3.162277639e-01f, 2.738419771e-01f, 2.371373773e-01f, 2.053525001e-01f, 1.778279394e-01f, 1.539926529e-01f, 1.333521456e-01f, 1.154781953e-01f, 1.000000015e-01f, 8.659642935e-02f, 7.498942316e-02f, 6.493816525e-02f, 5.623413250e-02f, 4.869675264e-02f, 4.216964915e-02f, 3.651741147e-02f, 3.162277490e-02f, 2.738419548e-02f, 2.371373773e-02f, 2.053525113e-02f, 1.778279431e-02f, 1.539926510e-02f, 1.333521400e-02f, 1.154781971e-02f, 9.999999776e-03f, 8.659643121e-03f, 7.498942316e-03f, 6.493816152e-03f, 5.623413250e-03f, 4.869675264e-03f, 4.216964822e-03f, 3.651741194e-03f, 3.162277630e-03f, 2.738419687e-03f, 2.371373819e-03f, 2.053525066e-03f, 1.778279431e-03f, 1.539926510e-03f, 1.333521446e-03f, 1.154782018e-03f, 1.000000047e-03f, 8.659643354e-04f, 7.498941850e-04f, 6.493816036e-04f, 5.623413017e-04f, 4.869675322e-04f, 4.216965172e-04f, 3.651741135e-04f, 3.162277571e-04f, 2.738419571e-04f, 2.371373703e-04f, 2.053525095e-04f, 1.778279402e-04f, 1.539926598e-04f, 1.333521504e-04f, 1.154782003e-04f};

__device__ void phase0(const Params& p) {
  const int total = 4 * 3008 + 32;
  for (int t = blockIdx.x; t < total; t += gridDim.x) {
    if (t < 4 * 3008) {
      const int L = t / 3008, u = t % 3008, jl = L >> 1;
      u16* wl = p.wbf + (long)L * W_PER_LAYER;
      if (u < 640) {
        const float* W = ((L & 1) ? p.od_w_in : p.ev_w_in) + (long)jl * DM * ZN;
        conv_weight_tile(W, wl + WOFF_IN, DM, ZN, (L & 1) ? 5 : 4, u % 40, u / 40, 0);
      } else if (u < 896) {
        const int v = u - 640;
        const float* W = ((L & 1) ? p.od_w_out : p.ev_w_out) + (long)jl * DM * DM;
        conv_weight_tile(W, wl + WOFF_OUT, DM, DM, 3, v % 16, v / 16, 0);
      } else if (u < 2304) {
        const int v = u - 896;
        const float* W = p.ffn_w_in + (long)L * DM * (2 * DFF);
        conv_weight_tile(W, wl + WOFF_FI, DM, 2 * DFF, 2, v % 88, v / 88, 0);
      } else {
        const int v = u - 2304;
        const float* W = p.ffn_w_out + (long)L * DFF * DM;
        conv_weight_tile(W, wl + WOFF_FO, DFF, DM, 3, v % 16, v / 16, 0);
      }
    } else {
      const int v = t - 4 * 3008;
      const int mat = v >> 2, tt = v & 3;
      conv_weight_tile(p.ev_pool_w + (long)mat * 16384, p.poolwt + (long)mat * 16384, 128, 128, 0, tt & 1, tt >> 1, 128);
    }
  }
  const int tid0 = wave_l() * 64 + lane_l();
  for (int r = blockIdx.x; r < NTILE; r += gridDim.x) {
    for (int e = tid0; e < 256 * 64; e += 512) {
      const int row = e >> 6, i = e & 63;
      const long tok = (long)r * 256 + row;
      const float ang = (float)p.pos[tok] * INV_FREQ[i];
      float sv, cv;
      sincosf(ang, &sv, &cv);
      p.rope[tok * 128 + i * 2] = cv;
      p.rope[tok * 128 + i * 2 + 1] = sv;
    }
    for (int e = tid0; e < 256 * 256; e += 512) {
      const long row = (long)r * 256 + (e >> 8);
      const int col = (e & 255) * 4;
      float4 v = *(const float4*)(p.x + row * DM + col);
      uint2 o; o.x = pack2(v.x, v.y); o.y = pack2(v.z, v.w);
      *(uint2*)((char*)p.hb + hbt_off(row, col)) = o;
    }
  }
}

__device__ void ln_rows(const u16* yb, float* hf, u16* hb, long row0, const float* __restrict__ g, const float* __restrict__ b, float* stats, const bool writef32) {
  const int w = wave_l(), lane = lane_l();
  const int ksel = lane >> 4, rsel = (lane >> 3) & 1, p8 = lane & 7;
  const int cbase = ksel * 32 + p8 * 4;
  for (int pr = 0; pr < 16; ++pr) {
    const long row = row0 + w * 32 + pr * 2 + rsel;
    const u16* yp = yb + row * DM + cbase;
    float4 v[8];
    float s = 0.f;
#pragma unroll
    for (int s8 = 0; s8 < 8; ++s8) {
      const uint2 yv = *(const uint2*)(yp + s8 * 128);
      v[s8] = make_float4(hlo(yv.x), hhi(yv.x), hlo(yv.y), hhi(yv.y));
      s += v[s8].x + v[s8].y + v[s8].z + v[s8].w;
    }
    s += __shfl_xor(s, 1); s += __shfl_xor(s, 2); s += __shfl_xor(s, 4); s += __shfl_xor(s, 16); s += __shfl_xor(s, 32);
    const float mu = s * (1.0f / 1024.0f);
    float s2 = 0.f;
#pragma unroll
    for (int s8 = 0; s8 < 8; ++s8) {
      v[s8].x -= mu; v[s8].y -= mu; v[s8].z -= mu; v[s8].w -= mu;
      s2 += v[s8].x * v[s8].x + v[s8].y * v[s8].y + v[s8].z * v[s8].z + v[s8].w * v[s8].w;
    }
    s2 += __shfl_xor(s2, 1); s2 += __shfl_xor(s2, 2); s2 += __shfl_xor(s2, 4); s2 += __shfl_xor(s2, 16); s2 += __shfl_xor(s2, 32);
    const float rstd = rsqrtf(s2 * (1.0f / 1024.0f) + LN_EPS);
    if ((lane & 55) == 0) { float2 st; st.x = mu; st.y = rstd; *(float2*)(stats + row * 2) = st; }
#pragma unroll
    for (int s8 = 0; s8 < 8; ++s8) {
      const int col = s8 * 128 + cbase;
      const float4 g4 = *(const float4*)(g + col), b4 = *(const float4*)(b + col);
      float4 o;
      o.x = v[s8].x * rstd * g4.x + b4.x; o.y = v[s8].y * rstd * g4.y + b4.y;
      o.z = v[s8].z * rstd * g4.z + b4.z; o.w = v[s8].w * rstd * g4.w + b4.w;
      if (writef32) *(float4*)(hf + row * DM + col) = o;
      uint2 ob; ob.x = pack2(o.x, o.y); ob.y = pack2(o.z, o.w);
      *(uint2*)((char*)hb + hbt_off(row, col)) = ob;
    }
  }
}

__device__ void retention_item(const Params& p, int item) {
  extern __shared__ __attribute__((aligned(16))) char smem[];
  const int eq = item & 3, h = (item >> 2) & 3, b = item >> 4;
  char* Qs = smem;
  char* Ks = smem + 34816;
  char* Ps = smem + 69632;
  char* Vs = smem + 104448;
  char* V2 = smem + 114688;
  char* STs = smem + 124928;
  const int w = wave_l(), lane = lane_l(), tid = w * 64 + lane, fr = lane & 15, fq = lane >> 4;
  const float lg2 = log2f(1.0f - exp2f(-5.0f - (float)h));
  const float cdec = exp2f(128.0f * lg2);
  f32x4 sacc[2];
  sacc[0] = (f32x4){0.f, 0.f, 0.f, 0.f}; sacc[1] = sacc[0];
  for (int i = tid; i < 8704 / 4; i += 512) ((unsigned*)STs)[i] = 0u;
  const int lrow = tid >> 4, lch = tid & 15;
  uint4 rq0, rq1, rq2, rq3, rk0, rk1, rk2, rk3, rv;
#define RET_LOAD(T0) do { \
    const u16* _zq = p.z + ((T0) + lrow) * ZW + h * 128 + lch * 8; \
    rq0 = *(const uint4*)(_zq); rk0 = *(const uint4*)(_zq + 512); \
    rq1 = *(const uint4*)(_zq + 32L * ZW); rk1 = *(const uint4*)(_zq + 32L * ZW + 512); \
    rq2 = *(const uint4*)(_zq + 64L * ZW); rk2 = *(const uint4*)(_zq + 64L * ZW + 512); \
    rq3 = *(const uint4*)(_zq + 96L * ZW); rk3 = *(const uint4*)(_zq + 96L * ZW + 512); \
    rv = *(const uint4*)(p.z + ((T0) + (tid >> 2)) * ZW + 1024 + h * 128 + eq * 32 + (tid & 3) * 8); } while (0)
  RET_LOAD((long)b * SEQ);
  for (int n = 0; n < 32; ++n) {
    const long tok0 = (long)b * SEQ + n * 128;
    *(uint4*)(Qs + (lrow + 0) * 272 + lch * 16) = rq0; *(uint4*)(Qs + (lrow + 32) * 272 + lch * 16) = rq1;
    *(uint4*)(Qs + (lrow + 64) * 272 + lch * 16) = rq2; *(uint4*)(Qs + (lrow + 96) * 272 + lch * 16) = rq3;
    *(uint4*)(Ks + (lrow + 0) * 272 + lch * 16) = rk0; *(uint4*)(Ks + (lrow + 32) * 272 + lch * 16) = rk1;
    *(uint4*)(Ks + (lrow + 64) * 272 + lch * 16) = rk2; *(uint4*)(Ks + (lrow + 96) * 272 + lch * 16) = rk3;
    {
      const int row = tid >> 2, ch = tid & 3;
      const uint4 v = rv;
      *(uint4*)(Vs + row * 80 + ch * 16) = v;
      const float kd = exp2f((float)(127 - row) * lg2);
      uint4 sv;
      sv.x = pack2(bflo(v.x) * kd, bfhi(v.x) * kd); sv.y = pack2(bflo(v.y) * kd, bfhi(v.y) * kd);
      sv.z = pack2(bflo(v.z) * kd, bfhi(v.z) * kd); sv.w = pack2(bflo(v.w) * kd, bfhi(v.w) * kd);
      *(uint4*)(V2 + row * 80 + ch * 16) = sv;
    }
    __syncthreads();
    if (n + 1 < 32) { RET_LOAD(tok0 + 128); }
    bf16x8 qf[4];
#pragma unroll
    for (int ks = 0; ks < 4; ++ks) qf[ks] = *(const bf16x8*)(Qs + (w * 16 + fr) * 272 + (ks * 32 + fq * 8) * 2);
    for (int jt = 0; jt < 8; ++jt) {
      uint2 pv; pv.x = 0u; pv.y = 0u;
      if (jt <= w) {
        f32x4 a = (f32x4){0.f, 0.f, 0.f, 0.f};
#pragma unroll
        for (int ks = 0; ks < 4; ++ks) {
          bf16x8 kf = *(const bf16x8*)(Ks + (jt * 16 + fr) * 272 + (ks * 32 + fq * 8) * 2);
          a = mfma16(kf, qf[ks], a);
        }
        const int i = w * 16 + fr;
        float o[4];
#pragma unroll
        for (int jj = 0; jj < 4; ++jj) {
          const int j = jt * 16 + fq * 4 + jj;
          const int d = i - j;
          o[jj] = (d >= 0) ? a[jj] * exp2f((float)d * lg2) : 0.f;
        }
        pv.x = pack2(o[0], o[1]); pv.y = pack2(o[2], o[3]);
      }
      *(uint2*)(Ps + (w * 16 + fr) * 272 + (jt * 16 + fq * 4) * 2) = pv;
    }
    __syncthreads();
    f32x4 oin[2], ocr[2];
    oin[0] = (f32x4){0.f, 0.f, 0.f, 0.f}; oin[1] = oin[0]; ocr[0] = oin[0]; ocr[1] = oin[0];
#pragma unroll
    for (int ks = 0; ks < 4; ++ks) {
      bf16x8 pf = *(const bf16x8*)(Ps + (w * 16 + fr) * 272 + (ks * 32 + fq * 8) * 2);
#pragma unroll
      for (int et = 0; et < 2; ++et) {
        bf16x8 vf = trfrag(Vs, 80, ks, et, lane);
        oin[et] = mfma16(vf, pf, oin[et]);
        bf16x8 sf = *(const bf16x8*)(STs + (et * 16 + fr) * 272 + (ks * 32 + fq * 8) * 2);
        ocr[et] = mfma16(sf, qf[ks], ocr[et]);
      }
    }
    {
      const int i = w * 16 + fr;
      const float qd = exp2f((float)(i + 1) * lg2);
      const long tok = tok0 + i;
      u16* rp = p.hid + (tok >> 8) * SLAB_ELEMS + (tok & 255) * 512 + h * 128 + eq * 32 + fq * 4;
#pragma unroll
      for (int et = 0; et < 2; ++et) {
        uint2 s;
        s.x = pack2(oin[et][0] + qd * ocr[et][0], oin[et][1] + qd * ocr[et][1]);
        s.y = pack2(oin[et][2] + qd * ocr[et][2], oin[et][3] + qd * ocr[et][3]);
        *(uint2*)(rp + et * 16) = s;
      }
    }
    __syncthreads();
    sacc[0] *= cdec; sacc[1] *= cdec;
#pragma unroll
    for (int ks = 0; ks < 4; ++ks) {
      bf16x8 kf = trfrag(Ks, 272, ks, w, lane);
#pragma unroll
      for (int et = 0; et < 2; ++et) {
        bf16x8 vf = trfrag(V2, 80, ks, et, lane);
        sacc[et] = mfma16(kf, vf, sacc[et]);
      }
    }
#pragma unroll
    for (int et = 0; et < 2; ++et) {
      uint2 s; s.x = pack2(sacc[et][0], sacc[et][1]); s.y = pack2(sacc[et][2], sacc[et][3]);
      *(uint2*)(STs + (et * 16 + fr) * 272 + (w * 16 + fq * 4) * 2) = s;
    }
    __syncthreads();
  }
}

__device__ void finalize_even(const Params& p, int L, int r) {
  extern __shared__ __attribute__((aligned(16))) char smem[];
  const int w = wave_l(), lane = lane_l(), tid = w * 64 + lane, fr = lane & 15, fq = lane >> 4;
  const int jl = L >> 1;
  u16* cat = p.hb;
  {
    const float* gn = p.ev_norm_g + jl * 512 + lane * 8;
    float gnv[8];
#pragma unroll
    for (int i = 0; i < 8; ++i) gnv[i] = gn[i];
    const u16* slab = p.hid + (long)r * SLAB_ELEMS;
    for (int rr = w; rr < 256; rr += 8) {
      const long tok = (long)r * 256 + rr;
      uint4 rv = *(const uint4*)(slab + rr * 512 + lane * 8);
      float v[8] = {bflo(rv.x), bfhi(rv.x), bflo(rv.y), bfhi(rv.y), bflo(rv.z), bfhi(rv.z), bflo(rv.w), bfhi(rv.w)};
      float s = 0.f;
#pragma unroll
      for (int i = 0; i < 8; ++i) s += v[i];
#pragma unroll
      for (int o = 8; o >= 1; o >>= 1) s += __shfl_xor(s, o);
      const float mu = s * (1.0f / 128.0f);
      float s2 = 0.f;
#pragma unroll
      for (int i = 0; i < 8; ++i) { v[i] -= mu; s2 += v[i] * v[i]; }
#pragma unroll
      for (int o = 8; o >= 1; o >>= 1) s2 += __shfl_xor(s2, o);
      const float rstd = rsqrtf(s2 * (1.0f / 128.0f) + LN_EPS);
      uint4 gv = *(const uint4*)(p.z + tok * ZW + 1536 + lane * 8);
      float g[8] = {bflo(gv.x), bfhi(gv.x), bflo(gv.y), bfhi(gv.y), bflo(gv.z), bfhi(gv.z), bflo(gv.w), bfhi(gv.w)};
      float o[8];
#pragma unroll
      for (int i = 0; i < 8; ++i) o[i] = v[i] * rstd * gnv[i] * (g[i] / (1.0f + __expf(-g[i])));
      uint4 ov; ov.x = pack2(o[0], o[1]); ov.y = pack2(o[2], o[3]); ov.z = pack2(o[4], o[5]); ov.w = pack2(o[6], o[7]);
      *(uint4*)(cat + tok * LDH + lane * 8) = ov;
    }
  }
  char* As = smem;
  char* Ws = smem + 69632;
  for (int gi = 0; gi < 4; ++gi) {
    const int win = 2 << gi;
    __syncthreads();
    {
      const u16* wt = p.poolwt + (long)(jl * 4 + gi) * 16384;
      for (int c = tid; c < 2048; c += 512) {
        const int row = c >> 4, ch = c & 15;
        *(uint4*)(Ws + row * 272 + ch * 16) = *(const uint4*)(wt + row * 128 + ch * 8);
      }
    }
    {
      const int oct = tid & 15, seg = tid >> 4;
      const long t0 = (long)r * 256 + seg * 8;
      const int pos0 = (int)(t0 & (SEQ - 1));
      const u16* pc = p.z + 2048 + gi * 128 + oct * 8;
      float s[8];
#pragma unroll
      for (int i = 0; i < 8; ++i) s[i] = 0.f;
      for (int k = 1; k < win; ++k) {
        if (pos0 - k >= 0) {
          uint4 v = *(const uint4*)(pc + (t0 - k) * ZW);
          s[0] += bflo(v.x); s[1] += bfhi(v.x); s[2] += bflo(v.y); s[3] += bfhi(v.y);
          s[4] += bflo(v.z); s[5] += bfhi(v.z); s[6] += bflo(v.w); s[7] += bfhi(v.w);
        }
      }
      for (int i = 0; i < 8; ++i) {
        const int pos = pos0 + i;
        uint4 v = *(const uint4*)(pc + (t0 + i) * ZW);
        float cur[8] = {bflo(v.x), bfhi(v.x), bflo(v.y), bfhi(v.y), bflo(v.z), bfhi(v.z), bflo(v.w), bfhi(v.w)};
        const float icnt = 1.0f / (float)min(pos + 1, win);
        float o[8];
#pragma unroll
        for (int q = 0; q < 8; ++q) { s[q] += cur[q]; o[q] = s[q] * icnt - cur[q]; }
        uint4 ov; ov.x = pack2(o[0], o[1]); ov.y = pack2(o[2], o[3]); ov.z = pack2(o[4], o[5]); ov.w = pack2(o[6], o[7]);
        *(uint4*)(As + (seg * 8 + i) * 272 + oct * 16) = ov;
        if (pos - win + 1 >= 0) {
          uint4 u = *(const uint4*)(pc + (t0 + i - win + 1) * ZW);
          s[0] -= bflo(u.x); s[1] -= bfhi(u.x); s[2] -= bflo(u.y); s[3] -= bfhi(u.y);
          s[4] -= bflo(u.z); s[5] -= bfhi(u.z); s[6] -= bflo(u.w); s[7] -= bfhi(u.w);
        }
      }
    }
    __syncthreads();
    const float* psc = p.ev_pool_scale + jl * 512 + gi * 128;
#pragma unroll
    for (int tt = 0; tt < 2; ++tt) {
      const int trow = (w * 2 + tt) * 16 + fr;
      bf16x8 af[4];
#pragma unroll
      for (int ks = 0; ks < 4; ++ks) af[ks] = *(const bf16x8*)(As + trow * 272 + (ks * 32 + fq * 8) * 2);
      const long tok = (long)r * 256 + trow;
      for (int dt = 0; dt < 8; ++dt) {
        f32x4 a = (f32x4){0.f, 0.f, 0.f, 0.f};
#pragma unroll
        for (int ks = 0; ks < 4; ++ks) {
          bf16x8 wf = *(const bf16x8*)(Ws + (dt * 16 + fr) * 272 + (ks * 32 + fq * 8) * 2);
          a = mfma16(wf, af[ks], a);
        }
        float4 sc = *(const float4*)(psc + dt * 16 + fq * 4);
        uint2 ov; ov.x = pack2(a[0] * sc.x, a[1] * sc.y); ov.y = pack2(a[2] * sc.z, a[3] * sc.w);
        *(uint2*)(cat + tok * LDH + 512 + gi * 128 + dt * 16 + fq * 4) = ov;
      }
    }
  }
  __syncthreads();
}

template <int MODE>
__device__ void lru_tile(const Params& p, int L, int r) {
  extern __shared__ __attribute__((aligned(16))) char smem[];
  const int w = wave_l(), lane = lane_l(), tid = w * 64 + lane;
  const int jl = L >> 1, c = tid;
  float* ub = (float*)smem + w * 64;
  hf32x2 w2[64];
  {
    const float* ga = p.od_ga_w + (long)jl * 32768 + w * 4096 + lane;
    const float* gx = p.od_gx_w + (long)jl * 32768 + w * 4096 + lane;
#pragma unroll
    for (int k = 0; k < 64; ++k) { w2[k][0] = ga[k * 64]; w2[k][1] = gx[k * 64]; }
  }
  const float cw0 = p.od_conv_w[jl * 2048 + c], cw1 = p.od_conv_w[jl * 2048 + 512 + c];
  const float cw2 = p.od_conv_w[jl * 2048 + 1024 + c], cw3 = p.od_conv_w[jl * 2048 + 1536 + c];
  const float cb = p.od_conv_b[jl * 512 + c], ba = p.od_ga_b[jl * 512 + c], bx = p.od_gx_b[jl * 512 + c];
  const float lam = p.od_lam[jl * 512 + c];
  const float sp = (lam > 15.f) ? __expf(-lam) : log1pf(__expf(-lam));
  const int pos0 = (r & 15) * 256;
  const long tok0 = (long)r * 256;
  const u16* zu = p.z + 512 + c;
  float u1 = 0.f, u2 = 0.f, u3 = 0.f;
  if (pos0 > 0) { u1 = bf1(zu[(tok0 - 1) * ZW]); u2 = bf1(zu[(tok0 - 2) * ZW]); u3 = bf1(zu[(tok0 - 3) * ZW]); }
  float hst = 0.f, Ac = 1.f;
  float* aout = (float*)((char*)(p.hid + (long)r * SLAB_ELEMS) + 786432) + c;
  if (MODE == 1) {
    const int ti = r & 15;
    for (int tt = 0; tt < ti; ++tt) {
      const float2 ah = *(const float2*)(p.agg + ((long)(r - ti + tt) * 512 + c) * 2);
      hst = ah.x * hst + ah.y;
    }
  }
  for (int t8 = 0; t8 < 64; ++t8) {
    float ubat[4], gbat[4];
#pragma unroll
    for (int i = 0; i < 4; ++i) {
      ubat[i] = bf1(zu[(tok0 + t8 * 4 + i) * ZW]);
      if (MODE == 1) gbat[i] = bf1(p.z[(tok0 + t8 * 4 + i) * ZW + c]);
    }
#pragma unroll
    for (int i = 0; i < 4; ++i) {
      const float u0 = ubat[i];
      const float uc = cw0 * u3 + cw1 * u2 + cw2 * u1 + cw3 * u0 + cb;
      u3 = u2; u2 = u1; u1 = u0;
      ub[lane] = uc;
      hf32x2 r2a = {ba, bx}, r2b = {0.f, 0.f};
#pragma unroll
      for (int k4 = 0; k4 < 16; ++k4) {
        const float4 v = ((const float4*)ub)[k4];
        r2a = __builtin_elementwise_fma((hf32x2){v.x, v.x}, w2[4 * k4], r2a);
        r2b = __builtin_elementwise_fma((hf32x2){v.y, v.y}, w2[4 * k4 + 1], r2b);
        r2a = __builtin_elementwise_fma((hf32x2){v.z, v.z}, w2[4 * k4 + 2], r2a);
        r2b = __builtin_elementwise_fma((hf32x2){v.w, v.w}, w2[4 * k4 + 3], r2b);
        if ((k4 & 3) == 3) __builtin_amdgcn_sched_barrier(0);
      }
      const float ra = r2a[0] + r2b[0], rx = r2a[1] + r2b[1];
      const float rg = __frcp_rn(1.0f + __expf(-ra));
      const float ig = __frcp_rn(1.0f + __expf(-rx));
      const float la = -8.0f * rg * sp;
      const float a = __expf(la);
      const float xq = -2.0f * la;
      const float om = (xq < 0.25f) ? xq * (1.0f - xq * (0.5f - xq * (0.16666667f - xq * (0.041666668f - xq * 0.0083333338f))))
                                    : (1.0f - __expf(-xq));
      const float bq = __builtin_amdgcn_sqrtf(om) * (ig * uc);
      if (MODE == 0) {
        const u16 bqb = f2bf(bq);
        aout[(t8 * 4 + i) * 512] = a;
        p.hb[(tok0 + t8 * 4 + i) * LDH + c] = bqb;
        hst = a * hst + bf1(bqb);
      } else {
        hst = a * hst + bq;
      }
      if (MODE == 0) Ac *= a;
      if (MODE == 1) {
        const float g = gbat[i];
        const float ge = 0.5f * g * (1.0f + tanhf(0.7978845608028654f * (g + 0.044715f * g * g * g)));
        p.hb[(tok0 + t8 * 4 + i) * LDH + c] = f2bf(hst * ge);
      }
    }
  }
  if (MODE == 0) {
    float2 ah; ah.x = Ac; ah.y = hst;
    *(float2*)(p.agg + ((long)r * 512 + c) * 2) = ah;
  }
  __syncthreads();
}

__device__ void lru_gate_tile(const Params& p, int L, int r) {
  extern __shared__ __attribute__((aligned(16))) char smem[];
  const int w = wave_l(), lane = lane_l(), fr = lane & 15, fq = lane >> 4;
  const int jl = L >> 1, c = w * 64 + lane;
  char* wl = smem + w * 11264;
  char* U = wl;
  float* Ga = (float*)(wl + 2304);
  float* Gx = (float*)(wl + 2304 + 4352);
  bf16x8 wfa[4][2], wfx[4][2];
  {
    const float* ga = p.od_ga_w + (long)jl * 32768 + w * 4096;
    const float* gx = p.od_gx_w + (long)jl * 32768 + w * 4096;
#pragma unroll
    for (int dt = 0; dt < 4; ++dt)
#pragma unroll
      for (int ks = 0; ks < 2; ++ks) {
        const int k0 = ks * 32 + fq * 8, d = dt * 16 + fr;
        unsigned a4[4], x4[4];
#pragma unroll
        for (int j = 0; j < 4; ++j) {
          a4[j] = pack2(ga[(k0 + 2 * j) * 64 + d], ga[(k0 + 2 * j + 1) * 64 + d]);
          x4[j] = pack2(gx[(k0 + 2 * j) * 64 + d], gx[(k0 + 2 * j + 1) * 64 + d]);
        }
        typedef unsigned u32x4_ __attribute__((ext_vector_type(4)));
        wfa[dt][ks] = __builtin_bit_cast(bf16x8, (u32x4_){a4[0], a4[1], a4[2], a4[3]});
        wfx[dt][ks] = __builtin_bit_cast(bf16x8, (u32x4_){x4[0], x4[1], x4[2], x4[3]});
      }
  }
  const float cw0 = p.od_conv_w[jl * 2048 + c], cw1 = p.od_conv_w[jl * 2048 + 512 + c];
  const float cw2 = p.od_conv_w[jl * 2048 + 1024 + c], cw3 = p.od_conv_w[jl * 2048 + 1536 + c];
  const float cb = p.od_conv_b[jl * 512 + c], ba = p.od_ga_b[jl * 512 + c], bx = p.od_gx_b[jl * 512 + c];
  const float lam = p.od_lam[jl * 512 + c];
  const float sp = (lam > 15.f) ? __expf(-lam) : log1pf(__expf(-lam));
  const int pos0 = (r & 15) * 256;
  const long tok0 = (long)r * 256;
  const u16* zu = p.z + 512 + c;
  float u1 = 0.f, u2 = 0.f, u3 = 0.f;
  if (pos0 > 0) { u1 = bf1(zu[(tok0 - 1) * ZW]); u2 = bf1(zu[(tok0 - 2) * ZW]); u3 = bf1(zu[(tok0 - 3) * ZW]); }
  float hst = 0.f, Ac = 1.f;
  float* aout = (float*)((char*)(p.hid + (long)r * SLAB_ELEMS) + 786432) + c;
  u16 unext[16];
#pragma unroll
  for (int i = 0; i < 16; ++i) unext[i] = zu[(tok0 + i) * ZW];
  for (int g16 = 0; g16 < 16; ++g16) {
    float ucv[16];
#pragma unroll
    for (int i = 0; i < 16; ++i) {
      const float u0 = bf1(unext[i]);
      ucv[i] = cw0 * u3 + cw1 * u2 + cw2 * u1 + cw3 * u0 + cb;
      u3 = u2; u2 = u1; u1 = u0;
      *(u16*)(U + i * 144 + lane * 2) = f2bf(ucv[i]);
    }
    if (g16 < 15) {
#pragma unroll
      for (int i = 0; i < 16; ++i) unext[i] = zu[(tok0 + (g16 + 1) * 16 + i) * ZW];
    }
    const bf16x8 uf0 = *(const bf16x8*)(U + fr * 144 + (fq * 8) * 2);
    const bf16x8 uf1 = *(const bf16x8*)(U + fr * 144 + (32 + fq * 8) * 2);
#pragma unroll
    for (int dt = 0; dt < 4; ++dt) {
      f32x4 da = (f32x4){0.f, 0.f, 0.f, 0.f}, dx = (f32x4){0.f, 0.f, 0.f, 0.f};
      da = mfma16(wfa[dt][0], uf0, da); da = mfma16(wfa[dt][1], uf1, da);
      dx = mfma16(wfx[dt][0], uf0, dx); dx = mfma16(wfx[dt][1], uf1, dx);
      *(float4*)(Ga + fr * 68 + dt * 16 + fq * 4) = make_float4(da[0], da[1], da[2], da[3]);
      *(float4*)(Gx + fr * 68 + dt * 16 + fq * 4) = make_float4(dx[0], dx[1], dx[2], dx[3]);
    }
#pragma unroll
    for (int i = 0; i < 16; ++i) {
      const float uc = ucv[i];
      const float ra = Ga[i * 68 + lane] + ba, rx = Gx[i * 68 + lane] + bx;
      const float rg = __frcp_rn(1.0f + __expf(-ra));
      const float ig = __frcp_rn(1.0f + __expf(-rx));
      const float la = -8.0f * rg * sp;
      const float a = __expf(la);
      const float xq = -2.0f * la;
      const float om = (xq < 0.25f) ? xq * (1.0f - xq * (0.5f - xq * (0.16666667f - xq * (0.041666668f - xq * 0.0083333338f))))
                                    : (1.0f - __expf(-xq));
      const float bq = __builtin_amdgcn_sqrtf(om) * (ig * uc);
      const u16 bqb = f2bf(bq);
      aout[(g16 * 16 + i) * 512] = a;
      p.hb[(tok0 + g16 * 16 + i) * LDH + c] = bqb;
      hst = a * hst + bf1(bqb);
      Ac *= a;
    }
  }
  float2 ah; ah.x = Ac; ah.y = hst;
  *(float2*)(p.agg + ((long)r * 512 + c) * 2) = ah;
  __syncthreads();
}

__device__ __forceinline__ void attn_decode(const int item, int& pat, int& h, int& dil, int& blk, long& tokb) {
  pat = item >> 11;
  const int q0 = item & 2047, b = q0 >> 7, q2 = q0 & 127, s = q2 & 31;
  h = q2 >> 5;
  dil = (pat == 0) ? 1 : (pat == 1 ? 4 : 16);
  const int nblk = 32 / dil;
  const int rr = s / nblk;
  blk = s % nblk;
  tokb = (long)b * SEQ + rr;
}

__device__ void attn_items(const Params& p, const int item0, const int nitems) {
  extern __shared__ __attribute__((aligned(16))) char smem[];
  const int w = wave_l(), lane = lane_l(), tid = w * 64 + lane, fr = lane & 15, fq = lane >> 4;
  char* KVs = smem;
  char* Qs = smem + 69632;
  char* Ps = smem + 69632;
  const int lrow = tid >> 4, lch = tid & 15;
  uint4 qr0, qr1, qr2, qr3, kr[8], vr[8];
  int pat, h, dil, blk; long tokb;
  if (nitems > 0) {
    attn_decode(item0, pat, h, dil, blk, tokb);
#define QLD(dst, j, TB, DL, BK, HH) dst = *(const uint4*)(p.z + ((TB) + (long)(DL) * (128 * (BK) + lrow + 32 * (j))) * ZW + 1024 + (HH) * 128 + lch * 8)
    QLD(qr0, 0, tokb, dil, blk, h); QLD(qr1, 1, tokb, dil, blk, h); QLD(qr2, 2, tokb, dil, blk, h); QLD(qr3, 3, tokb, dil, blk, h);
#pragma unroll
    for (int j = 0; j < 8; ++j) {
      const int row = lrow + 32 * j;
      kr[j] = make_uint4(0u, 0u, 0u, 0u);
      if (blk > 0 || row >= 128) {
        const long tok = tokb + (long)dil * (128 * (blk - 1) + row);
        kr[j] = *(const uint4*)(p.z + tok * ZW + 1536 + h * 128 + lch * 8);
      }
    }
  }
  for (int n = 0; n < nitems; ++n) {
    attn_decode(item0 + n, pat, h, dil, blk, tokb);
    *(uint4*)(Qs + (lrow + 0) * 272 + lch * 16) = qr0; *(uint4*)(Qs + (lrow + 32) * 272 + lch * 16) = qr1;
    *(uint4*)(Qs + (lrow + 64) * 272 + lch * 16) = qr2; *(uint4*)(Qs + (lrow + 96) * 272 + lch * 16) = qr3;
#pragma unroll
    for (int j = 0; j < 8; ++j) *(uint4*)(KVs + (lrow + 32 * j) * 272 + lch * 16) = kr[j];
#pragma unroll
    for (int j = 0; j < 8; ++j) {
      const int row = lrow + 32 * j;
      vr[j] = make_uint4(0u, 0u, 0u, 0u);
      if (blk > 0 || row >= 128) {
        const long tok = tokb + (long)dil * (128 * (blk - 1) + row);
        vr[j] = *(const uint4*)(p.z + tok * ZW + 2048 + h * 128 + lch * 8);
      }
    }
    __syncthreads();
    bf16x8 qf[4];
#pragma unroll
    for (int ks = 0; ks < 4; ++ks) qf[ks] = *(const bf16x8*)(Qs + (w * 16 + fr) * 272 + (ks * 32 + fq * 8) * 2);
    f32x4 sc[9];
    const int i = w * 16 + fr;
    float mx = -3.0e38f;
#pragma unroll
    for (int tt = 0; tt < 9; ++tt) {
      const int kt = w + tt;
      f32x4 a = (f32x4){0.f, 0.f, 0.f, 0.f};
#pragma unroll
      for (int ks = 0; ks < 4; ++ks) {
        bf16x8 kf = *(const bf16x8*)(KVs + (kt * 16 + fr) * 272 + (ks * 32 + fq * 8) * 2);
        a = mfma16(kf, qf[ks], a);
      }
#pragma unroll
      for (int jj = 0; jj < 4; ++jj) {
        const int kk = kt * 16 + fq * 4 + jj;
        const int rel = i + 128 - kk;
        const bool valid = (rel >= 0) && (rel <= 128) && (blk > 0 || kk >= 128);
        a[jj] = valid ? a[jj] : -3.0e38f;
        mx = fmaxf(mx, a[jj]);
      }
      sc[tt] = a;
    }
    mx = fmaxf(mx, __shfl_xor(mx, 16));
    mx = fmaxf(mx, __shfl_xor(mx, 32));
    float den = 0.f;
#pragma unroll
    for (int tt = 0; tt < 9; ++tt)
#pragma unroll
      for (int jj = 0; jj < 4; ++jj) {
        const float e = (sc[tt][jj] > -1.0e38f) ? __expf(sc[tt][jj] - mx) : 0.f;
        sc[tt][jj] = e; den += e;
      }
    den += __shfl_xor(den, 16);
    den += __shfl_xor(den, 32);
    __syncthreads();
    for (int c = lane; c < 528; c += 64) *(uint4*)(Ps + w * 16 * 528 + c * 16) = make_uint4(0u, 0u, 0u, 0u);
#pragma unroll
    for (int tt = 0; tt < 9; ++tt) {
      uint2 pv; pv.x = pack2(sc[tt][0], sc[tt][1]); pv.y = pack2(sc[tt][2], sc[tt][3]);
      *(uint2*)(Ps + (w * 16 + fr) * 528 + ((w + tt) * 16 + fq * 4) * 2) = pv;
    }
#pragma unroll
    for (int j = 0; j < 8; ++j) *(uint4*)(KVs + (lrow + 32 * j) * 272 + lch * 16) = vr[j];
    if (n + 1 < nitems) {
      int pat2, h2, dil2, blk2; long tokb2;
      attn_decode(item0 + n + 1, pat2, h2, dil2, blk2, tokb2);
      QLD(qr0, 0, tokb2, dil2, blk2, h2); QLD(qr1, 1, tokb2, dil2, blk2, h2); QLD(qr2, 2, tokb2, dil2, blk2, h2); QLD(qr3, 3, tokb2, dil2, blk2, h2);
#pragma unroll
      for (int j = 0; j < 8; ++j) {
        const int row = lrow + 32 * j;
        kr[j] = make_uint4(0u, 0u, 0u, 0u);
        if (blk2 > 0 || row >= 128) {
          const long tok = tokb2 + (long)dil2 * (128 * (blk2 - 1) + row);
          kr[j] = *(const uint4*)(p.z + tok * ZW + 1536 + h2 * 128 + lch * 8);
        }
      }
    }
    __syncthreads();
    f32x4 oacc[8];
#pragma unroll
    for (int et = 0; et < 8; ++et) oacc[et] = (f32x4){0.f, 0.f, 0.f, 0.f};
    const int ks_lo = w >> 1, ks_hi = (16 * w + 143) >> 5;
    for (int ks = ks_lo; ks <= ks_hi; ++ks) {
      bf16x8 pf = *(const bf16x8*)(Ps + (w * 16 + fr) * 528 + (ks * 32 + fq * 8) * 2);
#pragma unroll
      for (int et = 0; et < 8; ++et) {
        bf16x8 vf = trfrag(KVs, 272, ks, et, lane);
        oacc[et] = mfma16(vf, pf, oacc[et]);
      }
    }
    {
      const float inv = 1.0f / den;
      const long tok = tokb + (long)dil * (128 * blk + i);
      u16* op = p.hid + (tok >> 8) * SLAB_ELEMS + (long)pat * (256 * 512) + (tok & 255) * 512 + h * 128 + fq * 4;
#pragma unroll
      for (int et = 0; et < 8; ++et) {
        uint2 ov; ov.x = pack2(oacc[et][0] * inv, oacc[et][1] * inv); ov.y = pack2(oacc[et][2] * inv, oacc[et][3] * inv);
        *(uint2*)(op + et * 16) = ov;
      }
      if (fq == 0) p.lse[((long)pat * NTOK + tok) * 4 + h] = mx + __logf(den);
    }
    __syncthreads();
  }
}

__device__ void lru_final(const Params& p, int L, int r) {
  const int w = wave_l(), lane = lane_l(), c = w * 64 + lane;
  const long tok0 = (long)r * 256;
  const int ti = r & 15;
  float hst = 0.f;
  for (int tt = 0; tt < ti; ++tt) {
    const float2 ah = *(const float2*)(p.agg + ((long)(r - ti + tt) * 512 + c) * 2);
    hst = ah.x * hst + ah.y;
  }
  const float* ap = (const float*)((const char*)(p.hid + (long)r * SLAB_ELEMS) + 786432) + c;
  u16* bp = p.hb + tok0 * LDH + c;
  const u16* gp = p.z + tok0 * ZW + c;
  for (int t8 = 0; t8 < 32; ++t8) {
    float av[8], bv[8], gv[8];
#pragma unroll
    for (int i = 0; i < 8; ++i) {
      av[i] = ap[(t8 * 8 + i) * 512];
      bv[i] = bf1(bp[(long)(t8 * 8 + i) * LDH]);
      gv[i] = bf1(gp[(long)(t8 * 8 + i) * ZW]);
    }
#pragma unroll
    for (int i = 0; i < 8; ++i) {
      hst = av[i] * hst + bv[i];
      const float g = gv[i];
      const float ge = 0.5f * g * (1.0f + tanhf(0.7978845608028654f * (g + 0.044715f * g * g * g)));
      bp[(long)(t8 * 8 + i) * LDH] = f2bf(hst * ge);
    }
  }
  __syncthreads();
}

__device__ void finalize_odd(const Params& p, int L, int r) {
  lru_final(p, L, r);
  const int w = wave_l(), lane = lane_l(), tid = w * 64 + lane;
  const u16* slab = p.hid + (long)r * SLAB_ELEMS;
  u16* cat = p.hb;
  const int head = lane >> 4;
  for (int rr = w; rr < 256; rr += 8) {
    const long tok = (long)r * 256 + rr;
    const float l0 = p.lse[(0L * NTOK + tok) * 4 + head];
    const float l1 = p.lse[(1L * NTOK + tok) * 4 + head];
    const float l2 = p.lse[(2L * NTOK + tok) * 4 + head];
    const float m = fmaxf(l0, fmaxf(l1, l2));
    float e0 = __expf(l0 - m), e1 = __expf(l1 - m), e2 = __expf(l2 - m);
    const float inv = 1.0f / (e0 + e1 + e2);
    e0 *= inv; e1 *= inv; e2 *= inv;
    uint4 a = *(const uint4*)(slab + 0L * (256 * 512) + rr * 512 + lane * 8);
    uint4 bq = *(const uint4*)(slab + 1L * (256 * 512) + rr * 512 + lane * 8);
    uint4 cq = *(const uint4*)(slab + 2L * (256 * 512) + rr * 512 + lane * 8);
    uint4 ov;
    ov.x = pack2(e0 * bflo(a.x) + e1 * bflo(bq.x) + e2 * bflo(cq.x), e0 * bfhi(a.x) + e1 * bfhi(bq.x) + e2 * bfhi(cq.x));
    ov.y = pack2(e0 * bflo(a.y) + e1 * bflo(bq.y) + e2 * bflo(cq.y), e0 * bfhi(a.y) + e1 * bfhi(bq.y) + e2 * bfhi(cq.y));
    ov.z = pack2(e0 * bflo(a.z) + e1 * bflo(bq.z) + e2 * bflo(cq.z), e0 * bfhi(a.z) + e1 * bfhi(bq.z) + e2 * bfhi(cq.z));
    ov.w = pack2(e0 * bflo(a.w) + e1 * bflo(bq.w) + e2 * bflo(cq.w), e0 * bfhi(a.w) + e1 * bfhi(bq.w) + e2 * bfhi(cq.w));
    *(uint4*)(cat + tok * LDH + 512 + lane * 8) = ov;
  }
  __syncthreads();
}

template <int K, int epi>
__device__ void gemm_phase(const Params& p, const u16* A, const u16* Bt, const int nN, const int Lw, const float* res, const u16* resb, u16* ydst, const int lnidx) {
  const int nM = NTILE, nwg = nM * nN, G = gridDim.x, c = blockIdx.x;
  for (int i = 0;; ++i) {
    const long Lq = (long)i * G + c;
    if (Lq >= nwg) break;
    int wgid = (int)Lq;
    {
      const int q = nwg / 8, r = nwg % 8, xcd = wgid % 8, off = wgid / 8;
      wgid = (xcd < r ? xcd * (q + 1) : r * (q + 1) + (xcd - r) * q) + off;
    }
    const int nig = 8 * nN, gid = wgid / nig, fm = gid * 8, gsz = (nM - fm) < 8 ? (nM - fm) : 8;
    const int pm = fm + ((wgid % nig) % gsz), pn = (wgid % nig) / gsz;
    EpiArgs ea;
    ea.row0 = pm * 256; ea.mode = 0; ea.z = p.z; ea.rope = p.rope; ea.res = res; ea.resb = resb; ea.yb = ydst;
    ea.hid = p.hid + (long)pm * SLAB_ELEMS;
    ea.stats = p.stats; ea.lnmode = (lnidx >= 0) ? 1 : 0;
    ea.lng = p.ln_g + (lnidx >= 0 ? lnidx : 0) * DM; ea.lnb = p.ln_b + (lnidx >= 0 ? lnidx : 0) * DM;
    if (epi == EPI_IN) {
      if (Lw & 1) ea.mode = (pn >= 4 && pn < 6) ? 2 : ((pn >= 6 && pn < 8) ? 1 : 0);
      else ea.mode = (pn < 2) ? 2 : (pn < 4 ? 1 : 0);
    }
    gemm_tile<K, epi>(A, Bt, pm * 256, pn * 256, ea);
  }
  __syncthreads();
}

#define XB_TMO      128
#define XB_XCNT(j)  (256  + 64 * (j))
#define XB_XSUB(j)  (1280 + 64 * (j))
#define XB_XGEN(j)  (2304 + 64 * (j))
#define XB_TOP      3328
#define XB_TOPGEN   3392
#define XCD_BAR_WORDS 3456
#define XB_SPIN_CAP (1u << 18)
__device__ __forceinline__ unsigned xb_ld(unsigned* p)              { return __hip_atomic_load(p, __ATOMIC_RELAXED, __HIP_MEMORY_SCOPE_AGENT); }
__device__ __forceinline__ unsigned xb_add(unsigned* p, unsigned v) { return __hip_atomic_fetch_add(p, v, __ATOMIC_RELAXED, __HIP_MEMORY_SCOPE_AGENT); }
__device__ __forceinline__ unsigned xb_xcc_id() { return (unsigned)__builtin_amdgcn_s_getreg((3 << 11) | 20) & 0xFu; }
#define XB_SPIN(cond, bar) do { unsigned _sp = 0; while (cond) { __builtin_amdgcn_s_sleep(1); \
    if ((++_sp & 255u) == 0u) { if (xb_ld(&(bar)[XB_TMO])) break; if (_sp > XB_SPIN_CAP) { atomicAdd(&(bar)[XB_TMO], 1u); break; } } } } while (0)

__device__ __forceinline__ void xcd_barrier(unsigned* bar, const unsigned x, const unsigned nloc, const unsigned nx) {
  asm volatile("s_waitcnt vmcnt(0)" ::: "memory");
  __syncthreads();
  if (threadIdx.x == 0) {
    __builtin_amdgcn_s_waitcnt(0);
    const unsigned old = xb_add(&bar[XB_XSUB(x)], 1u);
    const unsigned gen = old / nloc;
    if (old + 1u == (gen + 1u) * nloc) {
      __builtin_amdgcn_fence(__ATOMIC_RELEASE, "agent");
      asm volatile("s_waitcnt vmcnt(0)" ::: "memory");
      const unsigned og = xb_add(&bar[XB_TOP], 1u);
      const unsigned tg = og / nx;
      if (og + 1u == (tg + 1u) * nx) xb_add(&bar[XB_TOPGEN], 1u);
      else XB_SPIN(xb_ld(&bar[XB_TOPGEN]) == tg, bar);
      __builtin_amdgcn_fence(__ATOMIC_ACQUIRE, "agent");
      xb_add(&bar[XB_XGEN(x)], 1u);
      asm volatile("s_waitcnt vmcnt(0)" ::: "memory");
    } else {
      XB_SPIN(xb_ld(&bar[XB_XGEN(x)]) == gen, bar);
      __builtin_amdgcn_fence(__ATOMIC_ACQUIRE, "agent");
      asm volatile("s_waitcnt vmcnt(0)" ::: "memory");
    }
  }
  __syncthreads();
}

#ifndef DUP_GEMM
#define DUP_GEMM 0
#endif
__global__ void __launch_bounds__(512) mega(Params p, int ph0, int ph1) {
  cg::grid_group grid = cg::this_grid();
  unsigned* bar = p.bar;
  const unsigned myx = xb_xcc_id();
  unsigned nloc = 1u, nx = 1u;
  if (threadIdx.x == 0) (void)xb_add(&bar[XB_XCNT(myx)], 1u);
  for (int ph = ph0; ph < ph1; ++ph) {
    if (ph == 0) {
      phase0(p);
    } else {
      const int L = (ph - 1) >> 3, k = (ph - 1) & 7;
      u16* ybm = (u16*)p.hf;
      const u16* wl = p.wbf + (long)L * W_PER_LAYER;
      if (k == 0) {
        for (int rep = 0; rep <= DUP_GEMM; ++rep) gemm_phase<DM, EPI_IN>(p, p.hb, wl + WOFF_IN, 10, L, p.x, ybm, ybm, -1);
      } else if (k == 1) {
        if (L & 1) {
          for (int it = blockIdx.x; it < 256; it += gridDim.x) lru_gate_tile(p, L, it);
          const int i0 = (int)((long)blockIdx.x * 6144 / gridDim.x), i1 = (int)((long)(blockIdx.x + 1) * 6144 / gridDim.x);
          attn_items(p, i0, i1 - i0);
        } else {
          for (int it = blockIdx.x; it < 256; it += gridDim.x) retention_item(p, it);
        }
      } else if (k == 2) {
        for (int r = blockIdx.x; r < NTILE; r += gridDim.x) {
          if (L & 1) finalize_odd(p, L, r); else finalize_even(p, L, r);
        }
      } else if (k == 3) {
        for (int rep = 0; rep <= DUP_GEMM; ++rep) gemm_phase<DM, EPI_RES>(p, p.hb, wl + WOFF_OUT, 4, L, p.x, ybm, ybm, (L == 0) ? -1 : (L - 1) * 2 + 1);
      } else if (k == 4 || k == 7) {
        const int which = (k == 4) ? 0 : 1;
        for (int r = blockIdx.x; r < NTILE; r += gridDim.x)
          ln_rows((L == 3 && which == 1) ? (const u16*)p.z : ybm, p.hf, p.hb, (long)r * 256, p.ln_g + (L * 2 + which) * DM, p.ln_b + (L * 2 + which) * DM, p.stats, (L == 3 && which == 1));
      } else if (k == 5) {
        for (int rep = 0; rep <= DUP_GEMM; ++rep) gemm_phase<DM, EPI_SWIGLU>(p, p.hb, wl + WOFF_FI, 22, L, p.x, ybm, ybm, -1);
      } else {
        for (int rep = 0; rep <= DUP_GEMM; ++rep) gemm_phase<DFF, EPI_RES>(p, p.hid, wl + WOFF_FO, 4, L, p.x, ybm, (L == 3) ? p.z : ybm, L * 2);
      }
    }
    if (ph + 1 < ph1) {
      if (ph == ph0) {
        grid.sync();
        unsigned cnt = 0u, mine = 0u;
#pragma unroll
        for (unsigned j = 0; j < 16; ++j) { const unsigned c = xb_ld(&bar[XB_XCNT(j)]); cnt += (c > 0u) ? 1u : 0u; mine = (j == myx) ? c : mine; }
        nloc = (unsigned)__builtin_amdgcn_readfirstlane(mine > 0u ? mine : 1u);
        nx = (unsigned)__builtin_amdgcn_readfirstlane(cnt > 0u ? cnt : 1u);
      } else {
        xcd_barrier(bar, myx, nloc, nx);
      }
    }
  }
}

extern "C" void kernel_launch(void* const* d_in, const int* in_sizes, int n_in, void* d_out, int out_size,
                              void* d_ws, size_t ws_size, hipStream_t stream) {
  Params p{};
  p.x = (const float*)d_in[0]; p.pos = (const int*)d_in[1];
  p.ev_w_in = (const float*)d_in[2]; p.ev_norm_g = (const float*)d_in[3]; p.ev_pool_w = (const float*)d_in[4];
  p.ev_pool_scale = (const float*)d_in[5]; p.ev_w_out = (const float*)d_in[6];
  p.od_w_in = (const float*)d_in[7]; p.od_conv_w = (const float*)d_in[8]; p.od_conv_b = (const float*)d_in[9];
  p.od_ga_w = (const float*)d_in[10]; p.od_ga_b = (const float*)d_in[11]; p.od_gx_w = (const float*)d_in[12];
  p.od_gx_b = (const float*)d_in[13]; p.od_lam = (const float*)d_in[14]; p.od_w_out = (const float*)d_in[15];
  p.ffn_w_in = (const float*)d_in[16]; p.ffn_w_out = (const float*)d_in[17];
  p.ln_g = (const float*)d_in[18]; p.ln_b = (const float*)d_in[19];
  p.hf = (float*)d_out;
  char* ws = (char*)d_ws;
  size_t off = 0;
  p.wbf = (u16*)(ws + off); off += (size_t)4 * W_PER_LAYER * 2;
  p.poolwt = (u16*)(ws + off); off += (size_t)8 * 16384 * 2;
  p.rope = (float*)(ws + off); off += (size_t)NTOK * 128 * 4;
  p.hb = (u16*)(ws + off); off += (size_t)NTOK * LDH * 2;
  p.z = (u16*)(ws + off); off += (size_t)NTOK * ZW * 2;
  p.hid = (u16*)(ws + off); off += (size_t)NTOK * LDHID * 2;
  p.lse = (float*)(ws + off); off += (size_t)3 * NTOK * 4 * 4;
  p.agg = (float*)(ws + off); off += (size_t)NTILE * 512 * 2 * 4;
  p.stats = (float*)(ws + off); off += (size_t)NTOK * 2 * 4;
  p.bar = (unsigned*)(ws + off); off += (size_t)XCD_BAR_WORDS * 4;
  if (off > ws_size) { fprintf(stderr, "workspace too small: need %zu have %zu\n", off, ws_size); return; }
  (void)hipFuncSetAttribute((const void*)mega, hipFuncAttributeMaxDynamicSharedMemorySize, DYN_LDS);
  static int grid_blocks = 0;
  if (!grid_blocks) {
    int dev = 0, cus = 0, per_cu = 0;
    (void)hipGetDevice(&dev);
    (void)hipDeviceGetAttribute(&cus, hipDeviceAttributeMultiprocessorCount, dev);
    (void)hipOccupancyMaxActiveBlocksPerMultiprocessor(&per_cu, mega, 512, DYN_LDS);
    if (per_cu < 1) per_cu = 1;
    grid_blocks = cus * per_cu;
    if (grid_blocks > 256) grid_blocks = 256;
  }
  (void)hipMemsetAsync(p.bar, 0, (size_t)XCD_BAR_WORDS * 4, stream);
  int ph0 = 0, ph1 = 33;
  void* args[] = {&p, &ph0, &ph1};
  hipError_t e = hipLaunchCooperativeKernel((const void*)mega, dim3(grid_blocks), dim3(512), args, DYN_LDS, stream);
  if (e != hipSuccess) fprintf(stderr, "cooperative launch failed: %s (grid %d)\n", hipGetErrorString(e), grid_blocks);
}
```
